# Optimizing an MI355X kernel written in HIP

```python
import jax
import jax.numpy as jnp
from jax import lax
import numpy as np

D_MODEL = 2048
BATCH = 4
SEQ = 2048
DEPTH = 2

CTX_LEN = 256
GRID_W = 64

N_GLA_HEADS = 4
GLA_KEY_DIM = D_MODEL // 2
GLA_VAL_DIM = D_MODEL
HEAD_K = GLA_KEY_DIM // N_GLA_HEADS
HEAD_V = GLA_VAL_DIM // N_GLA_HEADS
GATE_RANK = 16
GATE_TAU = 16.0
GLA_CHUNK = 64

CONV_DIM = D_MODEL
CONV_K = 3

D_FF = 5632
N_EXPERTS = 8
TOP_K = 2
N_DENSE = (DEPTH + 1) // 2
N_MOE = DEPTH // 2

EPS = 1e-6

OFF_Q = 0
OFF_K = OFF_Q + GLA_KEY_DIM
OFF_V = OFF_K + GLA_KEY_DIM
OFF_AF = OFF_V + GLA_VAL_DIM
OFF_AB = OFF_AF + GATE_RANK
CTX_COLS = OFF_AB + GATE_RANK
OFF_R = CTX_COLS
OFF_CB = OFF_R + GLA_VAL_DIM
OFF_CC = OFF_CB + CONV_DIM
OFF_CX = OFF_CC + CONV_DIM
OFF_GA = OFF_CX + CONV_DIM
OFF_GB = OFF_GA + D_MODEL
N_IN_COLS = OFF_GB + D_MODEL

kernel_name = 'hybrid_conv_gla_moe_dit'


def rmsnorm(x, g):
    xf = x.astype(jnp.float32)
    xf = xf * lax.rsqrt(jnp.mean(xf * xf, axis=-1, keepdims=True) + EPS)
    return (xf * g.astype(jnp.float32)).astype(x.dtype)


def modulate(h, shift, scale):
    return h * (1 + scale) + shift


def gla_inputs(p, w2_f, b_f, w2_b, b_b):
    lead = p.shape[:-1]

    def heads(t, hd):
        return t.reshape(*lead, -1, hd).astype(jnp.float32)

    q = heads(p[..., OFF_Q:OFF_K], HEAD_K) * (HEAD_K ** -0.5)
    k = heads(p[..., OFF_K:OFF_V], HEAD_K)
    v = heads(p[..., OFF_V:OFF_AF], HEAD_V)
    la_f = heads(jax.nn.log_sigmoid((p[..., OFF_AF:OFF_AB] @ w2_f + b_f).astype(jnp.float32)) / GATE_TAU, HEAD_K)
    la_b = heads(jax.nn.log_sigmoid((p[..., OFF_AB:CTX_COLS] @ w2_b + b_b).astype(jnp.float32)) / GATE_TAU, HEAD_K)
    return q, k, v, la_f, la_b


def gla_chunked(q, k, v, log_a, s0):
    bsz, length = q.shape[:2]
    n_chunks = length // GLA_CHUNK

    def to_chunks(t):
        return jnp.moveaxis(t.reshape(bsz, n_chunks, GLA_CHUNK, *t.shape[2:]), 1, 0)

    mask = jnp.tril(jnp.ones((GLA_CHUNK, GLA_CHUNK), dtype=bool))

    def step(s, inp):
        qc, kc, vc, ac = inp
        b = jnp.cumsum(ac, axis=1)
        b_last = b[:, -1]
        q_t = qc * jnp.exp(b)
        k_t = kc * jnp.exp(-b)
        att = jnp.where(mask, jnp.einsum('bchk,bshk->bhcs', q_t, k_t), 0.0)
        o = jnp.einsum('bhcs,bshv->bchv', att, vc) + jnp.einsum('bchk,bhkv->bchv', q_t, s)
        k_end = kc * jnp.exp(b_last[:, None] - b)
        s_new = jnp.exp(b_last)[..., None] * s + jnp.einsum('bchk,bchv->bhkv', k_end, vc)
        return s_new, o

    s_fin, o = lax.scan(step, s0, (to_chunks(q), to_chunks(k), to_chunks(v), to_chunks(log_a)))
    o = jnp.moveaxis(o, 0, 1).reshape(bsz, length, q.shape[2], v.shape[-1])
    return o, s_fin


def gla_bidirectional(q, k, v, la_f, la_b, s_f0, s_b0):
    o_f, s_f = gla_chunked(q, k, v, la_f, s_f0)

    def flip(t):
        return jnp.flip(t, axis=1)

    o_b, s_b = gla_chunked(flip(q), flip(k), flip(v), flip(la_b), s_b0)
    return o_f + flip(o_b), s_f, s_b


def dwconv_centred(u, w, b):
    pad = CONV_K // 2
    length = u.shape[-2]
    up = jnp.pad(u, [(0, 0)] * (u.ndim - 2) + [(pad, pad), (0, 0)])
    acc = b
    for j in range(CONV_K):
        acc = acc + up[..., j:j + length, :] * w[j]
    return acc


def merge_branches(p, o_gla, norm_g, cw, cb, w_a, w_b, w_o, rows):
    lead = p.shape[:-1]
    o = rmsnorm(o_gla, norm_g.reshape(N_GLA_HEADS, HEAD_V)).reshape(*lead, GLA_VAL_DIM).astype(p.dtype)
    y_b = (o * jax.nn.silu(p[..., OFF_R:OFF_CB])) @ w_b
    u = p[..., OFF_CC:OFF_CX] * p[..., OFF_CX:OFF_GA]
    if rows is None:
        conv = dwconv_centred(u, cw, cb)
    else:
        conv = dwconv_centred(u.reshape(lead[0], rows, GRID_W, CONV_DIM), cw, cb).reshape(u.shape)
    y_a = (p[..., OFF_CB:OFF_CC] * conv) @ w_a
    merged = jax.nn.sigmoid(p[..., OFF_GA:OFF_GB]) * y_a + jax.nn.sigmoid(p[..., OFF_GB:N_IN_COLS]) * y_b
    return merged @ w_o


def swiglu(h, w1, w3, w2):
    return (jax.nn.silu(h @ w1) * (h @ w3)) @ w2


def moe_swiglu(h, w_router, w1, w3, w2):
    flat = h.reshape(-1, h.shape[-1])
    logits = (flat @ w_router).astype(jnp.float32)
    top_v, top_i = lax.top_k(logits, TOP_K)
    probs = jax.nn.softmax(top_v, axis=-1)
    combine = jnp.sum(jax.nn.one_hot(top_i, N_EXPERTS, dtype=jnp.float32) * probs[..., None], axis=1)
    combine = combine.astype(h.dtype)
    out = jnp.zeros_like(flat)
    for e in range(N_EXPERTS):
        out = out + combine[:, e:e + 1] * swiglu(flat, w1[e], w3[e], w2[e])
    return out.reshape(h.shape)


def channel_mixer(h, layer, ffn_w1, ffn_w3, ffn_w2, router_w, moe_w1, moe_w3, moe_w2):
    i = layer // 2
    if layer % 2 == 0:
        return swiglu(h, ffn_w1[i], ffn_w3[i], ffn_w2[i])
    return moe_swiglu(h, router_w[i], moe_w1[i], moe_w3[i], moe_w2[i])


def setup_inputs(seed: int = 0) -> dict:
    key = jax.random.key(seed)
    ks = jax.random.split(key, 28)
    D = D_MODEL

    def nrm(k, shape, scale):
        return jax.random.normal(k, shape, jnp.float32) * scale

    def gain(k, shape):
        return 1.0 + 0.1 * jax.random.normal(k, shape, jnp.float32)

    return {
        'x': nrm(ks[0], (BATCH, SEQ, D), 1.0),
        'c': nrm(ks[1], (BATCH, D), 1.0),
        'ctx': nrm(ks[2], (BATCH, CTX_LEN, D), 1.0),
        'c_ctx': nrm(ks[3], (D,), 1.0),
        'w_ada': nrm(ks[4], (DEPTH, D, 6 * D), 0.5 * D ** -0.5),
        'b_ada': nrm(ks[5], (DEPTH, 6 * D), 0.05),
        'pre_mix_g': gain(ks[6], (DEPTH, D)),
        'post_mix_g': gain(ks[7], (DEPTH, D)),
        'pre_ffn_g': gain(ks[8], (DEPTH, D)),
        'post_ffn_g': gain(ks[9], (DEPTH, D)),
        'w_in': nrm(ks[10], (DEPTH, D, N_IN_COLS), D ** -0.5),
        'gate_w2_f': nrm(ks[11], (DEPTH, GATE_RANK, GLA_KEY_DIM), GATE_RANK ** -0.5),
        'gate_b_f': 1.0 + nrm(ks[12], (DEPTH, GLA_KEY_DIM), 0.5),
        'gate_w2_b': nrm(ks[13], (DEPTH, GATE_RANK, GLA_KEY_DIM), GATE_RANK ** -0.5),
        'gate_b_b': 1.0 + nrm(ks[14], (DEPTH, GLA_KEY_DIM), 0.5),
        'gla_norm_g': gain(ks[15], (DEPTH, GLA_VAL_DIM)),
        'conv_w': nrm(ks[16], (DEPTH, CONV_K, CONV_DIM), CONV_K ** -0.5),
        'conv_b': nrm(ks[17], (DEPTH, CONV_DIM), 0.02),
        'w_proj_a': nrm(ks[18], (DEPTH, CONV_DIM, D), CONV_DIM ** -0.5),
        'w_proj_b': nrm(ks[19], (DEPTH, GLA_VAL_DIM, D), GLA_VAL_DIM ** -0.5),
        'w_out': nrm(ks[20], (DEPTH, D, D), D ** -0.5),
        'ffn_w1': nrm(ks[21], (N_DENSE, D, D_FF), D ** -0.5),
        'ffn_w3': nrm(ks[22], (N_DENSE, D, D_FF), D ** -0.5),
        'ffn_w2': nrm(ks[23], (N_DENSE, D_FF, D), D_FF ** -0.5),
        'router_w': nrm(ks[24], (N_MOE, D, N_EXPERTS), D ** -0.5),
        'moe_w1': nrm(ks[25], (N_MOE, N_EXPERTS, D, D_FF), D ** -0.5),
        'moe_w3': nrm(ks[26], (N_MOE, N_EXPERTS, D, D_FF), D ** -0.5),
        'moe_w2': nrm(ks[27], (N_MOE, N_EXPERTS, D_FF, D), D_FF ** -0.5),
    }


def reference(x, c, ctx, c_ctx, w_ada, b_ada, pre_mix_g, post_mix_g, pre_ffn_g, post_ffn_g,
              w_in, gate_w2_f, gate_b_f, gate_w2_b, gate_b_b, gla_norm_g, conv_w, conv_b,
              w_proj_a, w_proj_b, w_out, ffn_w1, ffn_w3, ffn_w2, router_w, moe_w1, moe_w3, moe_w2):
    bsz = x.shape[0]
    rows = x.shape[1] // GRID_W
    xc = ctx
    for layer in range(DEPTH):
        last = layer == DEPTH - 1
        mod = jax.nn.silu(c) @ w_ada[layer] + b_ada[layer]
        sh1, sc1, g1, sh2, sc2, g2 = jnp.split(mod[:, None, :], 6, axis=-1)
        mod_c = jax.nn.silu(c_ctx) @ w_ada[layer] + b_ada[layer]
        csh1, csc1, cg1, csh2, csc2, cg2 = jnp.split(mod_c, 6, axis=-1)
        gate_p = (gate_w2_f[layer], gate_b_f[layer], gate_w2_b[layer], gate_b_b[layer])
        mix_p = (gla_norm_g[layer], conv_w[layer], conv_b[layer],
                 w_proj_a[layer], w_proj_b[layer], w_out[layer])
        w_in_l = w_in[layer]

        hc = modulate(rmsnorm(xc, pre_mix_g[layer]), csh1, csc1)
        pc = hc @ (w_in_l[:, :CTX_COLS] if last else w_in_l)
        s0 = jnp.zeros((bsz, N_GLA_HEADS, HEAD_K, HEAD_V), jnp.float32)
        o_c, s_f, s_b = gla_bidirectional(*gla_inputs(pc, *gate_p), s0, s0)

        hx = modulate(rmsnorm(x, pre_mix_g[layer]), sh1, sc1)
        px = hx @ w_in_l
        o_x, _, _ = gla_bidirectional(*gla_inputs(px, *gate_p), s_f, s_b)
        m_x = merge_branches(px, o_x.astype(jnp.float32), *mix_p, rows=rows)
        x = x + g1 * rmsnorm(m_x, post_mix_g[layer])

        h2 = modulate(rmsnorm(x, pre_ffn_g[layer]), sh2, sc2)
        f_x = channel_mixer(h2, layer, ffn_w1, ffn_w3, ffn_w2, router_w, moe_w1, moe_w3, moe_w2)
        x = x + g2 * rmsnorm(f_x, post_ffn_g[layer])

        if not last:
            m_c = merge_branches(pc, o_c, *mix_p, rows=None)
            xc = xc + cg1 * rmsnorm(m_c, post_mix_g[layer])
            h2c = modulate(rmsnorm(xc, pre_ffn_g[layer]), csh2, csc2)
            f_c = channel_mixer(h2c, layer, ffn_w1, ffn_w3, ffn_w2, router_w, moe_w1, moe_w3, moe_w2)
            xc = xc + cg2 * rmsnorm(f_c, post_ffn_g[layer])
    return x
```

```cpp
#include <hip/hip_runtime.h>
#include <cstdio>
#include <cstdint>

#define DI __device__ __forceinline__
typedef unsigned short bf16_t;
typedef float f32x4 __attribute__((ext_vector_type(4)));

constexpr int D = 2048, NBATCH = 4, SEQ = 2048, CTXL = 256;
constexpr int ML = NBATCH * SEQ, MC = NBATCH * CTXL, MT = ML + MC;
constexpr int HK = 256, HV = 512, NH = 4, DFF = 5632, NE = 8;
constexpr int NIN = 16416;
constexpr int OFF_Q = 0, OFF_K = 1024, OFF_V = 2048, OFF_AF = 4096, OFF_R = 4128, OFF_CB = 6176, OFF_CC = 8224, OFF_CX = 10272, OFF_GA = 12320, OFF_GB = 14368;
constexpr int PQ = 0, PK = 1024, PV = 2048, PSR = 4096, PCB = 6144, PU = 8192, PGA = 10240, PGB = 12288, LDP = 14336;
constexpr int NCH = MT / 64;
constexpr int MSORT = 18432;
constexpr float EPS = 1e-6f;

constexpr size_t al256(size_t x) { return (x + 255) & ~(size_t)255; }
constexpr size_t WS_CTL = 0, CTL_BYTES = 1u << 20;
constexpr size_t WS_MODP = WS_CTL + CTL_BYTES;
constexpr size_t WS_MOD = WS_MODP + al256((size_t)8 * 2 * 5 * 12288 * 4);
constexpr size_t WS_XS = WS_MOD + al256((size_t)2 * 5 * 12288 * 4);
constexpr size_t WS_H = WS_XS + (size_t)MT * D * 4;
constexpr size_t WS_PG = WS_H + (size_t)MT * D * 2;
constexpr size_t WS_P = WS_PG + (size_t)MT * 32 * 4;
constexpr size_t WS_GG = WS_P;
constexpr size_t P_BYTES = (size_t)MT * LDP * 2;
static_assert((size_t)MSORT * DFF * 2 <= P_BYTES, "GG overlay");
constexpr size_t WS_GLA = WS_P + P_BYTES;
constexpr size_t WS_QT = WS_GLA;
constexpr size_t WS_KET = WS_QT + (size_t)2 * MT * 1024 * 2;
constexpr size_t WS_VT = WS_KET + (size_t)2 * NCH * 4 * 256 * 64 * 2;
constexpr size_t WS_OI = WS_VT + (size_t)NCH * 4 * 512 * 64 * 2;
constexpr size_t WS_OF = WS_OI + (size_t)MT * D * 2;
constexpr size_t WS_GD = WS_OF + (size_t)2 * MT * D * 2;
constexpr size_t GLA_END = WS_GD + (size_t)2 * NCH * 1024 * 4;
constexpr size_t WS_HS = WS_GLA;
constexpr size_t WS_YS = WS_HS + (size_t)MSORT * D * 2;
constexpr size_t MOE_END = WS_YS + (size_t)MSORT * D * 4;
constexpr size_t WS_OBR = (GLA_END > MOE_END ? GLA_END : MOE_END);
constexpr size_t WS_YA = WS_OBR + (size_t)MT * D * 2;
constexpr size_t WS_MA = WS_YA + (size_t)MT * D * 2;
constexpr size_t WS_MRG = WS_MA + (size_t)MT * D * 4;
constexpr size_t WS_MM = WS_MRG + (size_t)MT * D * 2;
constexpr size_t WS_TOK = WS_MM + (size_t)MT * D * 4;
constexpr size_t WS_END = WS_TOK + (size_t)ML * 2 * 4 * 3;
constexpr int CW_BAR = 0;
constexpr int CW_CNT = 8192;
#ifndef FAST
#define FAST 0xFFFF
#endif
constexpr int FB_CONV = 1, FB_INPROJ = 2, FB_PA = 4, FB_PB = 8, FB_WO = 16, FB_F1 = 32, FB_F2 = 64, FB_G1 = 128, FB_G2 = 256;
constexpr size_t WS_WIN = WS_END;
constexpr size_t WS_WG = WS_WIN + (size_t)2 * 16384 * 2048 * 2;
constexpr size_t WS_WA = WS_WG + (size_t)2 * 64 * 2048 * 2;
constexpr size_t WS_WB = WS_WA + (size_t)2 * 2048 * 2048 * 2;
constexpr size_t WS_WO = WS_WB + (size_t)2 * 2048 * 2048 * 2;
constexpr size_t WS_F1 = WS_WO + (size_t)2 * 2048 * 2048 * 2;
constexpr size_t WS_F2 = WS_F1 + (size_t)11264 * 2048 * 2;
constexpr size_t WS_M1 = WS_F2 + (size_t)2048 * 5632 * 2;
constexpr size_t WS_M2 = WS_M1 + (size_t)8 * 11264 * 2048 * 2;
constexpr size_t WS_MMP = WS_M2 + (size_t)8 * 2048 * 5632 * 2;
constexpr size_t WS_YSP = WS_MMP + (size_t)4 * MC * D * 4;
constexpr size_t WS_END2 = WS_YSP + (size_t)4 * 2048 * D * 4;

struct Params {
    const float *x, *c, *ctx, *c_ctx, *w_ada, *b_ada, *pre_mix_g, *post_mix_g, *pre_ffn_g, *post_ffn_g, *w_in, *gate_w2_f, *gate_b_f, *gate_w2_b, *gate_b_b,
        *gla_norm_g, *conv_w, *conv_b, *w_proj_a, *w_proj_b, *w_out, *ffn_w1, *ffn_w3, *ffn_w2, *router_w, *moe_w1, *moe_w3, *moe_w2;
    float* out; unsigned char* ws; int ph_lo, ph_hi;
};

DI float bf2f(bf16_t v) { return __uint_as_float((unsigned)v << 16); }
DI bf16_t f2bf(float f) { unsigned u = __float_as_uint(f); u += 0x7FFFu + ((u >> 16) & 1u); return (bf16_t)(u >> 16); }
DI unsigned pack2(float lo, float hi) { return (unsigned)f2bf(lo) | ((unsigned)f2bf(hi) << 16); }
DI float siluf(float v) { return v / (1.f + __expf(-v)); }
DI float sigmf(float v) { return 1.f / (1.f + __expf(-v)); }
DI float wave_sum(float s) {
#pragma unroll
    for (int o = 32; o >= 1; o >>= 1) s += __shfl_xor(s, o);
    return s;
}
DI void ld_row_f32(const float* p, int lane, float (&v)[4][8]) {
#pragma unroll
    for (int j = 0; j < 4; ++j) { const float4* q = (const float4*)(p + (j * 64 + lane) * 8); const float4 a = q[0], b = q[1];
        v[j][0] = a.x; v[j][1] = a.y; v[j][2] = a.z; v[j][3] = a.w; v[j][4] = b.x; v[j][5] = b.y; v[j][6] = b.z; v[j][7] = b.w; }
}
DI void ld_row_part4(const float* p, size_t stride, int lane, float (&v)[4][8]) {
    float t[4][8]; ld_row_f32(p, lane, v);
#pragma unroll
    for (int s = 1; s < 4; ++s) { ld_row_f32(p + s * stride, lane, t);
#pragma unroll
        for (int j = 0; j < 4; ++j)
#pragma unroll
            for (int i = 0; i < 8; ++i) v[j][i] += t[j][i]; }
}
DI void ld_row_bf16(const bf16_t* p, int lane, float (&v)[4][8]) {
#pragma unroll
    for (int j = 0; j < 4; ++j) { const uint4 w = *(const uint4*)(p + (j * 64 + lane) * 8);
        v[j][0] = __uint_as_float(w.x << 16); v[j][1] = __uint_as_float(w.x & 0xffff0000u); v[j][2] = __uint_as_float(w.y << 16); v[j][3] = __uint_as_float(w.y & 0xffff0000u);
        v[j][4] = __uint_as_float(w.z << 16); v[j][5] = __uint_as_float(w.z & 0xffff0000u); v[j][6] = __uint_as_float(w.w << 16); v[j][7] = __uint_as_float(w.w & 0xffff0000u); }
}
DI void ld8_f32(const float* p, float (&v)[8]) { const float4* q = (const float4*)p; const float4 a = q[0], b = q[1]; v[0] = a.x; v[1] = a.y; v[2] = a.z; v[3] = a.w; v[4] = b.x; v[5] = b.y; v[6] = b.z; v[7] = b.w; }
DI void ld8_bf16(const bf16_t* p, float (&v)[8]) { const uint4 w = *(const uint4*)p;
    v[0] = __uint_as_float(w.x << 16); v[1] = __uint_as_float(w.x & 0xffff0000u); v[2] = __uint_as_float(w.y << 16); v[3] = __uint_as_float(w.y & 0xffff0000u);
    v[4] = __uint_as_float(w.z << 16); v[5] = __uint_as_float(w.z & 0xffff0000u); v[6] = __uint_as_float(w.w << 16); v[7] = __uint_as_float(w.w & 0xffff0000u); }
DI void st_row_f32(float* p, int lane, const float (&v)[4][8]) {
#pragma unroll
    for (int j = 0; j < 4; ++j) { float4* q = (float4*)(p + (j * 64 + lane) * 8); q[0] = make_float4(v[j][0], v[j][1], v[j][2], v[j][3]); q[1] = make_float4(v[j][4], v[j][5], v[j][6], v[j][7]); }
}
DI void st_row_bf16(bf16_t* p, int lane, const float (&v)[4][8]) {
#pragma unroll
    for (int j = 0; j < 4; ++j) { uint4 w; w.x = pack2(v[j][0], v[j][1]); w.y = pack2(v[j][2], v[j][3]); w.z = pack2(v[j][4], v[j][5]); w.w = pack2(v[j][6], v[j][7]); *(uint4*)(p + (j * 64 + lane) * 8) = w; }
}
DI float sumsq(const float (&v)[4][8]) { float s = 0.f;
#pragma unroll
    for (int j = 0; j < 4; ++j)
#pragma unroll
        for (int i = 0; i < 8; ++i) s += v[j][i] * v[j][i];
    return s; }

struct WsV {
    unsigned char* b;
    DI unsigned* ctl_() const { return (unsigned*)(b + WS_CTL); }
    DI float* modp_() const { return (float*)(b + WS_MODP); }
    DI float* mod_() const { return (float*)(b + WS_MOD); }
    DI bf16_t* xs_() const { return (bf16_t*)(b + WS_XS); }
    DI bf16_t* h_() const { return (bf16_t*)(b + WS_H); }
    DI float* pg_() const { return (float*)(b + WS_PG); }
    DI bf16_t* P_() const { return (bf16_t*)(b + WS_P); }
    DI bf16_t* gg_() const { return (bf16_t*)(b + WS_GG); }
    DI bf16_t* qt_() const { return (bf16_t*)(b + WS_QT); }
    DI bf16_t* ket_() const { return (bf16_t*)(b + WS_KET); }
    DI bf16_t* vt_() const { return (bf16_t*)(b + WS_VT); }
    DI bf16_t* oi_() const { return (bf16_t*)(b + WS_OI); }
    DI bf16_t* of_() const { return (bf16_t*)(b + WS_OF); }
    DI float* gd_() const { return (float*)(b + WS_GD); }
    DI bf16_t* hs_() const { return (bf16_t*)(b + WS_HS); }
    DI bf16_t* ys_() const { return (bf16_t*)(b + WS_YS); }
    DI bf16_t* obr_() const { return (bf16_t*)(b + WS_OBR); }
    DI bf16_t* ya_() const { return (bf16_t*)(b + WS_YA); }
    DI bf16_t* ma_() const { return (bf16_t*)(b + WS_MA); }
    DI bf16_t* mrg_() const { return (bf16_t*)(b + WS_MRG); }
    DI bf16_t* mm_() const { return (bf16_t*)(b + WS_MM); }
    DI int* toke_() const { return (int*)(b + WS_TOK); }
    DI int* tokp_() const { return (int*)(b + WS_TOK) + ML * 2; }
    DI float* tokw_() const { return (float*)(b + WS_TOK) + ML * 4; }
};
typedef WsV Ws;
DI Ws make_ws(unsigned char* w) { Ws s; s.b = w; return s; }
DI const float* mod_ptr(const Ws& w, int l, int row, int which) { const int mr = row < ML ? row / SEQ : 4; return w.mod_() + ((size_t)(l * 5 + mr) * 6 + which) * D; }

DI void ph_ada(const Params& p, const Ws& w, int bid, int nblk, unsigned char* ldsb) {
    float* sl = (float*)ldsb;
    const int tid = threadIdx.x, c4 = (tid & 63) * 4, kg = tid >> 6;
    for (int u = bid; u < 2 * 48 * 8; u += nblk) {
        const int ks = u & 7, cb = (u >> 3) % 48, l = u / (8 * 48);
        __syncthreads();
        for (int i = tid; i < 5 * 256; i += 512) { const int r = i >> 8, k = ks * 256 + (i & 255); const float v = r < 4 ? p.c[r * D + k] : p.c_ctx[k]; sl[i] = siluf(v); }
        __syncthreads();
        float acc[5][4];
#pragma unroll
        for (int r = 0; r < 5; ++r)
#pragma unroll
            for (int j = 0; j < 4; ++j) acc[r][j] = 0.f;
        const float* wp = p.w_ada + ((size_t)l * D + ks * 256 + kg * 32) * 12288 + cb * 256 + c4;
#pragma unroll 8
        for (int k = 0; k < 32; ++k) { const f32x4 wv = __builtin_nontemporal_load((const f32x4*)(wp + (size_t)k * 12288));
#pragma unroll
            for (int r = 0; r < 5; ++r) { const float sv = sl[r * 256 + kg * 32 + k];
#pragma unroll
                for (int j = 0; j < 4; ++j) acc[r][j] += sv * wv[j]; } }
        __syncthreads();
        float* red = sl + 5 * 256;
#pragma unroll
        for (int r = 0; r < 5; ++r) *(f32x4*)(red + (kg * 5 + r) * 256 + c4) = (f32x4){acc[r][0], acc[r][1], acc[r][2], acc[r][3]};
        __syncthreads();
        for (int i = tid; i < 5 * 256; i += 512) { const int r = i >> 8, c = i & 255; float sum = 0.f;
#pragma unroll
            for (int g = 0; g < 8; ++g) sum += red[(g * 5 + r) * 256 + c];
            w.modp_()[((size_t)(ks * 2 + l) * 5 + r) * 12288 + cb * 256 + c] = sum; }
    }
}
DI void ph_modfin(const Params& p, const Ws& w, int bid, int nblk) {
    for (int i = bid * 512 + threadIdx.x; i < 2 * 5 * 12288; i += nblk * 512) {
        const int col = i % 12288, l = i / (5 * 12288); float s = p.b_ada[l * 12288 + col];
#pragma unroll
        for (int ks = 0; ks < 8; ++ks) s += w.modp_()[(size_t)ks * 2 * 5 * 12288 + i];
        w.mod_()[i] = s;
    }
}

DI const float* xin_row(const Params& p, int r) { return r < ML ? p.x + (size_t)r * D : p.ctx + (size_t)(r - ML) * D; }
DI void norm_mod_store(const float (&v)[4][8], const float* g, const float* sh, const float* sc, bf16_t* dst, int lane, float (&hout)[4][8]) {
    const float rs = rsqrtf(wave_sum(sumsq(v)) * (1.f / D) + EPS);
    float gv[4][8], a[4][8], b[4][8]; ld_row_f32(g, lane, gv); ld_row_f32(sh, lane, a); ld_row_f32(sc, lane, b);
#pragma unroll
    for (int j = 0; j < 4; ++j)
#pragma unroll
        for (int i = 0; i < 8; ++i) hout[j][i] = v[j][i] * rs * gv[j][i] * (1.f + b[j][i]) + a[j][i];
    st_row_bf16(dst, lane, hout);
}
DI void ph_t1(const Params& p, const Ws& w, int bid, int nblk) {
    const int lane = threadIdx.x & 63, gw = bid * 8 + (threadIdx.x >> 6), nw = nblk * 8;
    for (int r = gw; r < MT; r += nw) {
        float v[4][8], h[4][8]; ld_row_f32(xin_row(p, r), lane, v);
        norm_mod_store(v, p.pre_mix_g, mod_ptr(w, 0, r, 0), mod_ptr(w, 0, r, 1), w.h_() + (size_t)r * D, lane, h);
    }
}
template <int L> DI void ph_t2(const Params& p, const Ws& w, int bid, int nblk, unsigned char* ldsb) {
    constexpr int MR = L == 0 ? MT : ML;
    const int lane = threadIdx.x & 63, gw = bid * 8 + (threadIdx.x >> 6), nw = nblk * 8;
    float* rw_s = (float*)ldsb;
    if (L == 1) { __syncthreads();
        for (int e = threadIdx.x; e < 2048; e += 512) { const float4 a = ((const float4*)p.router_w)[e * 2], b = ((const float4*)p.router_w)[e * 2 + 1];
            rw_s[e] = a.x; rw_s[2048 + e] = a.y; rw_s[4096 + e] = a.z; rw_s[6144 + e] = a.w; rw_s[8192 + e] = b.x; rw_s[10240 + e] = b.y; rw_s[12288 + e] = b.z; rw_s[14336 + e] = b.w; }
        __syncthreads(); }
    for (int r = gw; r < MR; r += nw) {
        float xr[4][8], m[4][8], gv[4][8], g1[4][8], h[4][8];
        if (L == 0) ld_row_f32(xin_row(p, r), lane, xr); else ld_row_bf16(w.xs_() + (size_t)r * D, lane, xr);
        if (L == 0 && (FAST & FB_WO) && r >= ML) ld_row_part4((const float*)(w.b + WS_MMP) + (size_t)(r - ML) * D, (size_t)MC * D, lane, m);
        else ld_row_bf16(w.mm_() + (size_t)r * D, lane, m);
        const float rs = rsqrtf(wave_sum(sumsq(m)) * (1.f / D) + EPS);
        ld_row_f32(p.post_mix_g + L * D, lane, gv); ld_row_f32(mod_ptr(w, L, r, 2), lane, g1);
#pragma unroll
        for (int j = 0; j < 4; ++j)
#pragma unroll
            for (int i = 0; i < 8; ++i) xr[j][i] += g1[j][i] * (m[j][i] * rs * gv[j][i]);
        st_row_bf16(w.xs_() + (size_t)r * D, lane, xr);
        norm_mod_store(xr, p.pre_ffn_g + L * D, mod_ptr(w, L, r, 3), mod_ptr(w, L, r, 4), w.h_() + (size_t)r * D, lane, h);
        if (L == 1) {
            float lg[8] = {0.f, 0.f, 0.f, 0.f, 0.f, 0.f, 0.f, 0.f};
#pragma unroll
            for (int j = 0; j < 4; ++j) {
#pragma unroll
                for (int ex = 0; ex < 8; ++ex) { const float4* rw = (const float4*)(rw_s + ex * 2048 + (j * 64 + lane) * 8); const float4 a = rw[0], b = rw[1];
                    lg[ex] += h[j][0] * a.x + h[j][1] * a.y + h[j][2] * a.z + h[j][3] * a.w + h[j][4] * b.x + h[j][5] * b.y + h[j][6] * b.z + h[j][7] * b.w;
                    if (ex & 1) asm volatile("" ::: "memory"); } }
#pragma unroll
            for (int e = 0; e < 8; ++e) lg[e] = wave_sum(lg[e]);
            if (lane == 0) {
                int e0 = 0; float v0 = lg[0];
#pragma unroll
                for (int e = 1; e < 8; ++e) if (lg[e] > v0) { v0 = lg[e]; e0 = e; }
                int e1 = -1; float v1 = -3.0e38f;
#pragma unroll
                for (int e = 0; e < 8; ++e) if (e != e0 && lg[e] > v1) { v1 = lg[e]; e1 = e; }
                const float p1 = 1.f / (1.f + __expf(v0 - v1)), p0 = 1.f - p1;
                const int q0 = (int)atomicAdd(w.ctl_() + CW_CNT + e0, 1u), q1 = (int)atomicAdd(w.ctl_() + CW_CNT + e1, 1u);
                w.toke_()[r * 2] = e0; w.toke_()[r * 2 + 1] = e1; w.tokp_()[r * 2] = q0; w.tokp_()[r * 2 + 1] = q1; w.tokw_()[r * 2] = p0; w.tokw_()[r * 2 + 1] = p1;
            }
        }
    }
}
DI void moe_offsets(const Ws& w, int (&off)[9]) { int o = 0;
#pragma unroll
    for (int e = 0; e < 8; ++e) { off[e] = o; const int c = (int)__hip_atomic_load(w.ctl_() + CW_CNT + e, __ATOMIC_RELAXED, __HIP_MEMORY_SCOPE_AGENT); o += (c + 255) & ~255; }
    off[8] = o; }
DI void ph_scatter(const Params& p, const Ws& w, int bid, int nblk) {
    int off[9]; moe_offsets(w, off);
    const int lane = threadIdx.x & 63, gw = bid * 8 + (threadIdx.x >> 6), nw = nblk * 8;
    for (int r = gw; r < ML; r += nw) {
        const uint4* __restrict__ src = (const uint4*)(w.h_() + (size_t)r * D);
        const uint4 v0 = src[lane], v1 = src[64 + lane], v2 = src[128 + lane], v3 = src[192 + lane];
        const int e0 = w.toke_()[r * 2], e1 = w.toke_()[r * 2 + 1], q0 = w.tokp_()[r * 2], q1 = w.tokp_()[r * 2 + 1];
        int o0 = 0, o1 = 0;
#pragma unroll
        for (int q = 0; q < 8; ++q) { o0 = (q == e0) ? off[q] : o0; o1 = (q == e1) ? off[q] : o1; }
        uint4* __restrict__ d0 = (uint4*)(w.hs_() + (size_t)(o0 + q0) * D); uint4* __restrict__ d1 = (uint4*)(w.hs_() + (size_t)(o1 + q1) * D);
        d0[lane] = v0; d0[64 + lane] = v1; d0[128 + lane] = v2; d0[192 + lane] = v3;
        d1[lane] = v0; d1[64 + lane] = v1; d1[128 + lane] = v2; d1[192 + lane] = v3;
    }
    for (int e = 0; e < 8; ++e) { const int c = (int)__hip_atomic_load(w.ctl_() + CW_CNT + e, __ATOMIC_RELAXED, __HIP_MEMORY_SCOPE_AGENT); const int lo = off[e] + c, hi = off[e + 1];
        for (int r = lo + gw; r < hi; r += nw) { uint4* dst = (uint4*)(w.hs_() + (size_t)r * D);
#pragma unroll
            for (int j = 0; j < 4; ++j) dst[j * 64 + lane] = make_uint4(0u, 0u, 0u, 0u); } }
}
template <int L> DI void ph_t3(const Params& p, const Ws& w, int bid, int nblk) {
    constexpr int MR = L == 0 ? MT : ML;
    int off[9]; if (L == 1) moe_offsets(w, off);
    const int lane = threadIdx.x & 63, gw = bid * 8 + (threadIdx.x >> 6), nw = nblk * 8;
    for (int r = gw; r < MR; r += nw) {
        float xr[4][8], f[4][8], gv[4][8], g2[4][8];
        ld_row_bf16(w.xs_() + (size_t)r * D, lane, xr);
        if (L == 0) { if ((FAST & FB_F2) && r >= ML) ld_row_part4((const float*)(w.b + WS_MMP) + (size_t)(r - ML) * D, (size_t)MC * D, lane, f); else ld_row_bf16(w.mm_() + (size_t)r * D, lane, f); }
        else {
            float y0[4][8], y1[4][8]; int o0 = 0, o1 = 0; const int e0 = w.toke_()[r * 2], e1 = w.toke_()[r * 2 + 1];
#pragma unroll
            for (int q = 0; q < 8; ++q) { o0 = (q == e0) ? off[q] : o0; o1 = (q == e1) ? off[q] : o1; }
            const int q0 = o0 + w.tokp_()[r * 2], q1 = o1 + w.tokp_()[r * 2 + 1];
            if ((FAST & FB_F2) && q0 >= 16384) ld_row_part4((const float*)(w.b + WS_YSP) + (size_t)(q0 - 16384) * D, (size_t)2048 * D, lane, y0); else ld_row_bf16(w.ys_() + (size_t)q0 * D, lane, y0);
            if ((FAST & FB_F2) && q1 >= 16384) ld_row_part4((const float*)(w.b + WS_YSP) + (size_t)(q1 - 16384) * D, (size_t)2048 * D, lane, y1); else ld_row_bf16(w.ys_() + (size_t)q1 * D, lane, y1);
            const float w0 = w.tokw_()[r * 2], w1 = w.tokw_()[r * 2 + 1];
#pragma unroll
            for (int j = 0; j < 4; ++j)
#pragma unroll
                for (int i = 0; i < 8; ++i) f[j][i] = w0 * y0[j][i] + w1 * y1[j][i];
        }
        const float rs = rsqrtf(wave_sum(sumsq(f)) * (1.f / D) + EPS);
        ld_row_f32(p.post_ffn_g + L * D, lane, gv); ld_row_f32(mod_ptr(w, L, r, 5), lane, g2);
#pragma unroll
        for (int j = 0; j < 4; ++j)
#pragma unroll
            for (int i = 0; i < 8; ++i) xr[j][i] += g2[j][i] * (f[j][i] * rs * gv[j][i]);
        if (L == 0) { st_row_bf16(w.xs_() + (size_t)r * D, lane, xr); float h[4][8];
            norm_mod_store(xr, p.pre_mix_g + D, mod_ptr(w, 1, r, 0), mod_ptr(w, 1, r, 1), w.h_() + (size_t)r * D, lane, h); }
        else st_row_f32(p.out + (size_t)r * D, lane, xr);
    }
}
template <int L> DI void ph_g3(const Params& p, const Ws& w, int bid, int nblk) {
    constexpr int MR = L == 0 ? MT : ML, RB = 4;
    const int lane = threadIdx.x & 63, gw = bid * 8 + (threadIdx.x >> 6), nw = nblk * 8;
#pragma unroll 1
    for (int rb = gw; rb < MR / RB; rb += nw) {
        const int r0 = rb * RB;
        const int pos0 = r0 < ML ? (r0 & 63) : ((r0 - ML) & 255), last = r0 < ML ? 63 : 255;
#pragma unroll
        for (int j = 0; j < 4; ++j) {
            const int e0 = (j * 64 + lane) * 8;
            float ng[8], cw0[8], cw1[8], cw2[8], cbv[8], ul[8], uc[8];
            ld8_f32(p.gla_norm_g + L * D + e0, ng);
            ld8_f32(p.conv_w + (size_t)L * 3 * D + e0, cw0); ld8_f32(p.conv_w + (size_t)L * 3 * D + D + e0, cw1); ld8_f32(p.conv_w + (size_t)L * 3 * D + 2 * D + e0, cw2);
            ld8_f32(p.conv_b + L * D + e0, cbv);
            if (pos0 != 0) ld8_bf16(w.P_() + (size_t)(r0 - 1) * LDP + PU + e0, ul); else {
#pragma unroll
                for (int i = 0; i < 8; ++i) ul[i] = 0.f; }
            ld8_bf16(w.P_() + (size_t)r0 * LDP + PU + e0, uc);
#pragma unroll
            for (int q = 0; q < RB; ++q) {
                const int r = r0 + q;
                float o[8], t[8], ur[8], cbg[8], y[8];
                if (pos0 + q != last) ld8_bf16(w.P_() + (size_t)(r + 1) * LDP + PU + e0, ur); else {
#pragma unroll
                    for (int i = 0; i < 8; ++i) ur[i] = 0.f; }
                ld8_bf16(w.oi_() + (size_t)r * D + e0, o); ld8_bf16(w.of_() + (size_t)r * D + e0, t);
#pragma unroll
                for (int i = 0; i < 8; ++i) o[i] += t[i];
                ld8_bf16(w.of_() + (size_t)(MT + r) * D + e0, t);
                float s = 0.f;
#pragma unroll
                for (int i = 0; i < 8; ++i) { o[i] += t[i]; s += o[i] * o[i]; }
                const float rs = rsqrtf(wave_sum(s) * (1.f / HV) + EPS);
                ld8_bf16(w.P_() + (size_t)r * LDP + PSR + e0, t);
                uint4 ov;
                ov.x = pack2(o[0] * rs * ng[0] * t[0], o[1] * rs * ng[1] * t[1]); ov.y = pack2(o[2] * rs * ng[2] * t[2], o[3] * rs * ng[3] * t[3]);
                ov.z = pack2(o[4] * rs * ng[4] * t[4], o[5] * rs * ng[5] * t[5]); ov.w = pack2(o[6] * rs * ng[6] * t[6], o[7] * rs * ng[7] * t[7]);
                *(uint4*)(w.obr_() + (size_t)r * D + e0) = ov;
                ld8_bf16(w.P_() + (size_t)r * LDP + PCB + e0, cbg);
#pragma unroll
                for (int i = 0; i < 8; ++i) y[i] = cbg[i] * (cbv[i] + cw0[i] * ul[i] + cw1[i] * uc[i] + cw2[i] * ur[i]);
                uint4 yv; yv.x = pack2(y[0], y[1]); yv.y = pack2(y[2], y[3]); yv.z = pack2(y[4], y[5]); yv.w = pack2(y[6], y[7]);
                *(uint4*)(w.ya_() + (size_t)r * D + e0) = yv;
#pragma unroll
                for (int i = 0; i < 8; ++i) { ul[i] = uc[i]; uc[i] = ur[i]; }
            }
            asm volatile("" ::: "memory");
        }
    }
}

struct WSrc { const float* w0; const float* w1; int ld; };
template <int NSRC, class WSel, class Epi>
DI void naive_gemm(const bf16_t* __restrict__ A, int lda, int M, int N, int K, WSel wsel, Epi epi, unsigned char* ldsb, int bid, int nblk) {
    float* As = (float*)ldsb; float* Wl = As + 16 * 68;
    const int tid = threadIdx.x, ty = tid >> 4, tx = tid & 15;
    const int ntm = M / 64, ntn = N / 64;
    for (int tile = bid; tile < ntm * ntn; tile += nblk) {
        const int tm = tile / ntn, tn = tile % ntn, m0 = tm * 64, n0 = tn * 64;
        const WSrc wsrc = wsel(m0, n0);
        float acc[NSRC][2][4];
#pragma unroll
        for (int s = 0; s < NSRC; ++s)
#pragma unroll
            for (int i = 0; i < 2; ++i)
#pragma unroll
                for (int j = 0; j < 4; ++j) acc[s][i][j] = 0.f;
        for (int k0 = 0; k0 < K; k0 += 16) {
            { const unsigned v = *(const unsigned*)(A + (size_t)(m0 + (tid >> 3)) * lda + k0 + (tid & 7) * 2);
              As[((tid & 7) * 2) * 68 + (tid >> 3)] = __uint_as_float(v << 16); As[((tid & 7) * 2 + 1) * 68 + (tid >> 3)] = __uint_as_float(v & 0xffff0000u); }
#pragma unroll
            for (int s = 0; s < NSRC; ++s) { const float2 wv = *(const float2*)((s == 0 ? wsrc.w0 : wsrc.w1) + (size_t)(k0 + (tid >> 5)) * wsrc.ld + (tid & 31) * 2);
                Wl[s * 16 * 68 + (tid >> 5) * 68 + (tid & 31) * 2] = wv.x; Wl[s * 16 * 68 + (tid >> 5) * 68 + (tid & 31) * 2 + 1] = wv.y; }
            __syncthreads();
#pragma unroll
            for (int kk = 0; kk < 16; ++kk) { const float a0 = As[kk * 68 + ty * 2], a1 = As[kk * 68 + ty * 2 + 1];
#pragma unroll
                for (int s = 0; s < NSRC; ++s) { const float4 wv = *(const float4*)(Wl + s * 16 * 68 + kk * 68 + tx * 4);
                    acc[s][0][0] += a0 * wv.x; acc[s][0][1] += a0 * wv.y; acc[s][0][2] += a0 * wv.z; acc[s][0][3] += a0 * wv.w;
                    acc[s][1][0] += a1 * wv.x; acc[s][1][1] += a1 * wv.y; acc[s][1][2] += a1 * wv.z; acc[s][1][3] += a1 * wv.w; } }
            __syncthreads();
        }
#pragma unroll
        for (int i = 0; i < 2; ++i)
#pragma unroll
            for (int j = 0; j < 4; ++j) epi(m0 + ty * 2 + i, n0 + tx * 4 + j, acc[0][i][j], acc[NSRC - 1][i][j]);
    }
}

template <int L> DI void ph_inproj_naive(const Params& p, const Ws& w, int bid, int nblk, unsigned char* lds) {
    const float* win = p.w_in + (size_t)L * D * NIN;
    auto epi = [&](int m, int n, float a0, float a1) {
        bf16_t* P = w.P_() + (size_t)m * LDP;
        if (n < PK) P[n] = f2bf(a0 * 0.0625f);
        else if (n < PSR) P[n] = f2bf(a0);
        else if (n < PCB) P[n] = f2bf(siluf(a0));
        else if (n < PU) P[n] = f2bf(a0);
        else if (n < PGA) P[n] = f2bf(a0 * a1);
        else if (n < LDP) P[n] = f2bf(sigmf(a0));
        else if (n < LDP + 32) w.pg_()[(size_t)m * 32 + (n - LDP)] = a0;
    };
    auto src1 = [&](int n) { return n < PSR ? n   : n < PCB ? OFF_R + (n - PSR) : n < PU ? OFF_CB + (n - PCB) : n < PGB ? OFF_GA + (n - PGA) : n < LDP ? OFF_GB + (n - PGB) : OFF_AF + (n - LDP); };
    naive_gemm<1>(w.h_(), D, MT, PU, D, [&](int, int n0) { return WSrc{win + src1(n0), nullptr, NIN}; }, epi, lds, bid, nblk);
    naive_gemm<1>(w.h_(), D, MT, LDP + 64 - PGA, D, [&](int, int n0) { return WSrc{win + src1(n0 + PGA), nullptr, NIN}; },
                  [&](int m, int n, float a0, float a1) { epi(m, n + PGA, a0, a1); }, lds, bid, nblk);
    naive_gemm<2>(w.h_(), D, MT, 2048, D, [&](int, int n0) { return WSrc{win + OFF_CC + n0, win + OFF_CX + n0, NIN}; },
                  [&](int m, int n, float a0, float a1) { epi(m, n + PU, a0, a1); }, lds, bid, nblk);
}
template <int L> DI void ph_pa_naive(const Params& p, const Ws& w, int bid, int nblk, unsigned char* lds) {
    constexpr int MR = L == 0 ? MT : ML; const float* W0 = p.w_proj_a + (size_t)L * D * D;
    naive_gemm<1>(w.ya_(), D, MR, D, D, [&](int, int n0) { return WSrc{W0 + n0, nullptr, D}; },
                  [&](int m, int n, float a0, float) { w.ma_()[(size_t)m * D + n] = f2bf(a0 * bf2f(w.P_()[(size_t)m * LDP + PGA + n])); }, lds, bid, nblk);
}
template <int L> DI void ph_pb_naive(const Params& p, const Ws& w, int bid, int nblk, unsigned char* lds) {
    constexpr int MR = L == 0 ? MT : ML; const float* W0 = p.w_proj_b + (size_t)L * D * D;
    naive_gemm<1>(w.obr_(), D, MR, D, D, [&](int, int n0) { return WSrc{W0 + n0, nullptr, D}; },
                  [&](int m, int n, float a0, float) { w.mrg_()[(size_t)m * D + n] = f2bf(bf2f(w.ma_()[(size_t)m * D + n]) + a0 * bf2f(w.P_()[(size_t)m * LDP + PGB + n])); }, lds, bid, nblk);
}
template <int L> DI void ph_wo_naive(const Params& p, const Ws& w, int bid, int nblk, unsigned char* lds) {
    constexpr int MR = L == 0 ? MT : ML; const float* W0 = p.w_out + (size_t)L * D * D;
    naive_gemm<1>(w.mrg_(), D, MR, D, D, [&](int, int n0) { return WSrc{W0 + n0, nullptr, D}; },
                  [&](int m, int n, float a0, float) { w.mm_()[(size_t)m * D + n] = f2bf(a0); }, lds, bid, nblk);
}
DI int expert_of_row(const int (&off)[9], int m0) { int e = 0;
#pragma unroll
    for (int q = 1; q < 8; ++q) e = (m0 >= off[q]) ? q : e;
    return e; }
template <int L> DI void ph_f1_naive(const Params& p, const Ws& w, int bid, int nblk, unsigned char* lds) {
    if (L == 0) {
        naive_gemm<2>(w.h_(), D, MT, DFF, D, [&](int, int n0) { return WSrc{p.ffn_w1 + n0, p.ffn_w3 + n0, DFF}; },
                      [&](int m, int n, float a0, float a1) { w.gg_()[(size_t)m * DFF + n] = f2bf(siluf(a0) * a1); }, lds, bid, nblk);
    } else {
        int off[9]; moe_offsets(w, off);
        naive_gemm<2>(w.hs_(), D, off[8], DFF, D, [&](int m0, int n0) { const size_t eo = (size_t)expert_of_row(off, m0) * D * DFF; return WSrc{p.moe_w1 + eo + n0, p.moe_w3 + eo + n0, DFF}; },
                      [&](int m, int n, float a0, float a1) { w.gg_()[(size_t)m * DFF + n] = f2bf(siluf(a0) * a1); }, lds, bid, nblk);
    }
}
template <int L> DI void ph_f2_naive(const Params& p, const Ws& w, int bid, int nblk, unsigned char* lds) {
    if (L == 0) {
        naive_gemm<1>(w.gg_(), DFF, MT, D, DFF, [&](int, int n0) { return WSrc{p.ffn_w2 + n0, nullptr, D}; },
                      [&](int m, int n, float a0, float) { w.mm_()[(size_t)m * D + n] = f2bf(a0); }, lds, bid, nblk);
    } else {
        int off[9]; moe_offsets(w, off);
        naive_gemm<1>(w.gg_(), DFF, off[8], D, DFF, [&](int m0, int n0) { return WSrc{p.moe_w2 + (size_t)expert_of_row(off, m0) * DFF * D + n0, nullptr, D}; },
                      [&](int m, int n, float a0, float) { w.ys_()[(size_t)m * D + n] = f2bf(a0); }, lds, bid, nblk);
    }
}

template <int L> DI void ph_g1_naive(const Params& p, const Ws& w, int bid, int nblk, unsigned char* lds) {
    bf16_t* qt_s = (bf16_t*)lds;
    bf16_t* kt_s = (bf16_t*)(lds + 65536);
    float* A_s = (float*)(lds + 131072);
    float* pg_s = A_s;
    const int tid = threadIdx.x, d = tid >> 8, k = tid & 255;
    for (int u = bid; u < NCH * NH; u += nblk) {
        const int cg = u >> 2, h = u & 3, r0 = cg * 64;
        __syncthreads();
        for (int i = tid; i < 64 * 32; i += 512) pg_s[i] = w.pg_()[(size_t)r0 * 32 + i];
        const float* w2 = (d == 0 ? p.gate_w2_f : p.gate_w2_b) + (size_t)L * 16 * 1024 + h * 256 + k;
        float wv[16];
#pragma unroll
        for (int r = 0; r < 16; ++r) wv[r] = w2[r * 1024];
        const float bias = (d == 0 ? p.gate_b_f : p.gate_b_b)[L * 1024 + h * 256 + k];
        __syncthreads();
        float tot = 0.f;
#pragma unroll 4
        for (int t = 0; t < 64; ++t) { float xg = bias;
#pragma unroll
            for (int r = 0; r < 16; ++r) xg += pg_s[t * 32 + d * 16 + r] * wv[r];
            tot += (fminf(xg, 0.f) - log1pf(__expf(-fabsf(xg)))) * 0.0625f; }
        float cum = 0.f;
#pragma unroll 1
        for (int c = 0; c < 8; ++c) {
            bf16_t kev[8];
#pragma unroll
            for (int i = 0; i < 8; ++i) {
                const int t = d ? 63 - (c * 8 + i) : c * 8 + i;
                float xg = bias;
#pragma unroll
                for (int r = 0; r < 16; ++r) xg += pg_s[t * 32 + d * 16 + r] * wv[r];
                cum += (fminf(xg, 0.f) - log1pf(__expf(-fabsf(xg)))) * 0.0625f;
                const size_t row = (size_t)(r0 + t);
                const float q = bf2f(w.P_()[row * LDP + PQ + h * 256 + k]), kk = bf2f(w.P_()[row * LDP + PK + h * 256 + k]);
                const bf16_t qtv = f2bf(q * __expf(cum)), ktv = f2bf(kk * __expf(-cum));
                kev[i] = f2bf(kk * __expf(tot - cum));
                qt_s[(d * 64 + t) * 256 + k] = qtv; kt_s[(d * 64 + t) * 256 + k] = ktv;
                w.qt_()[((size_t)d * MT + row) * 1024 + h * 256 + k] = qtv;
                asm volatile("" ::: "memory");
            }
            const int t0 = d ? 56 - c * 8 : c * 8;
            uint4 o;
            o.x = d ? ((unsigned)kev[7] | ((unsigned)kev[6] << 16)) : ((unsigned)kev[0] | ((unsigned)kev[1] << 16));
            o.y = d ? ((unsigned)kev[5] | ((unsigned)kev[4] << 16)) : ((unsigned)kev[2] | ((unsigned)kev[3] << 16));
            o.z = d ? ((unsigned)kev[3] | ((unsigned)kev[2] << 16)) : ((unsigned)kev[4] | ((unsigned)kev[5] << 16));
            o.w = d ? ((unsigned)kev[1] | ((unsigned)kev[0] << 16)) : ((unsigned)kev[6] | ((unsigned)kev[7] << 16));
            *(uint4*)(w.ket_() + ((((size_t)d * NCH + cg) * 4 + h) * 256 + k) * 64 + t0) = o;
        }
        w.gd_()[((size_t)d * NCH + cg) * 1024 + h * 256 + k] = __expf(tot);
        __syncthreads();
        { const int t = tid >> 3, s0 = (tid & 7) * 8;
#pragma unroll 1
          for (int j = 0; j < 8; ++j) { const int s = s0 + j; float a = 0.f;
              if (s <= t) { const bf16_t* qa = qt_s + t * 256; const bf16_t* ka = kt_s + s * 256; for (int c = 0; c < 256; ++c) a += bf2f(qa[c]) * bf2f(ka[c]); }
              if (s >= t) { const bf16_t* qa = qt_s + (64 + t) * 256; const bf16_t* ka = kt_s + (64 + s) * 256; for (int c = 0; c < 256; ++c) a += bf2f(qa[c]) * bf2f(ka[c]); }
              A_s[t * 64 + s] = a; } }
        __syncthreads();
        { const int n = tid; float vc[64];
#pragma unroll
          for (int s = 0; s < 64; ++s) vc[s] = bf2f(w.P_()[(size_t)(r0 + s) * LDP + PV + h * 512 + n]);
          { uint4* dst = (uint4*)(w.vt_() + (((size_t)cg * 4 + h) * 512 + n) * 64);
#pragma unroll
            for (int c = 0; c < 8; ++c) { uint4 o4;
                o4.x = (__float_as_uint(vc[c * 8 + 0]) >> 16) | (__float_as_uint(vc[c * 8 + 1]) & 0xffff0000u); o4.y = (__float_as_uint(vc[c * 8 + 2]) >> 16) | (__float_as_uint(vc[c * 8 + 3]) & 0xffff0000u);
                o4.z = (__float_as_uint(vc[c * 8 + 4]) >> 16) | (__float_as_uint(vc[c * 8 + 5]) & 0xffff0000u); o4.w = (__float_as_uint(vc[c * 8 + 6]) >> 16) | (__float_as_uint(vc[c * 8 + 7]) & 0xffff0000u);
                dst[c] = o4; } }
          for (int t = 0; t < 64; ++t) { float o = 0.f;
#pragma unroll
              for (int s = 0; s < 64; ++s) o += A_s[t * 64 + s] * vc[s];
              w.oi_()[(size_t)(r0 + t) * D + h * 512 + n] = f2bf(o); } }
    }
}
template <int L> DI void ph_g2_naive(const Params& p, const Ws& w, int bid, int nblk, unsigned char* lds) {
    float* S = (float*)lds;
    bf16_t* qt_s = (bf16_t*)(lds + 65536);
    bf16_t* ke_s = (bf16_t*)(lds + 98304);
    float* g_s = (float*)(lds + 131072);
    const int tid = threadIdx.x, n = tid & 63, tq = tid >> 6;
    for (int u = bid; u < 256; u += nblk) {
        const int j = u & 7, d = (u >> 3) & 1, h = (u >> 4) & 3, b = u >> 6;
        __syncthreads();
        for (int i = tid; i < 256 * 64; i += 512) S[i] = 0.f;
        for (int step = 0; step < 36; ++step) {
            int cg; if (step < 4) cg = 128 + b * 4 + (d ? 3 - step : step); else { const int c = step - 4; cg = b * 32 + (d ? 31 - c : c); }
            const int r0 = cg * 64;
            __syncthreads();
#pragma unroll
            for (int i = 0; i < 4; ++i) { const int idx = tid + i * 512, t = idx >> 5, kc = idx & 31;
                *(uint4*)(qt_s + t * 256 + kc * 8) = *(const uint4*)(w.qt_() + ((size_t)d * MT + r0 + t) * 1024 + h * 256 + kc * 8); }
            { const uint4* src = (const uint4*)(w.ket_() + (((size_t)d * NCH + cg) * 4 + h) * 256 * 64);
#pragma unroll
              for (int i = 0; i < 4; ++i) ((uint4*)ke_s)[tid + i * 512] = src[tid + i * 512]; }
            if (tid < 256) g_s[tid] = w.gd_()[((size_t)d * NCH + cg) * 1024 + h * 256 + tid];
            float vc[64];
            { const uint4* src = (const uint4*)(w.vt_() + (((size_t)cg * 4 + h) * 512 + j * 64 + n) * 64);
#pragma unroll
              for (int c = 0; c < 8; ++c) { const uint4 v = src[c];
                  vc[c * 8 + 0] = __uint_as_float(v.x << 16); vc[c * 8 + 1] = __uint_as_float(v.x & 0xffff0000u); vc[c * 8 + 2] = __uint_as_float(v.y << 16); vc[c * 8 + 3] = __uint_as_float(v.y & 0xffff0000u);
                  vc[c * 8 + 4] = __uint_as_float(v.z << 16); vc[c * 8 + 5] = __uint_as_float(v.z & 0xffff0000u); vc[c * 8 + 6] = __uint_as_float(v.w << 16); vc[c * 8 + 7] = __uint_as_float(v.w & 0xffff0000u); } }
            __syncthreads();
            { float acc[8] = {0.f, 0.f, 0.f, 0.f, 0.f, 0.f, 0.f, 0.f};
              for (int kk = 0; kk < 256; ++kk) { const float s = S[kk * 64 + n];
#pragma unroll
                  for (int i = 0; i < 8; ++i) acc[i] += bf2f(qt_s[(tq * 8 + i) * 256 + kk]) * s; }
#pragma unroll
              for (int i = 0; i < 8; ++i) w.of_()[((size_t)d * MT + r0 + tq * 8 + i) * D + h * 512 + j * 64 + n] = f2bf(acc[i]); }
            __syncthreads();
            for (int i = 0; i < 32; ++i) { const int kk = tq * 32 + i; float s = g_s[kk] * S[kk * 64 + n];
#pragma unroll
                for (int t = 0; t < 64; ++t) s += bf2f(ke_s[kk * 64 + t]) * vc[t];
                S[kk * 64 + n] = s; }
        }
    }
}

#define XB_TMO      128
#define XB_XCNT(j)  (256  + 64 * (j))
#define XB_XSUB(j)  (1280 + 64 * (j))
#define XB_XGEN(j)  (2304 + 64 * (j))
#define XB_TOP      3328
#define XB_TOPGEN   3392
#define XCD_BAR_WORDS 3456
#define XB_SPIN_CAP (1u << 18)
#define LAS __attribute__((address_space(3)))

__device__ __forceinline__ unsigned xb_ld(unsigned* p)              { return __hip_atomic_load(p, __ATOMIC_RELAXED, __HIP_MEMORY_SCOPE_AGENT); }
__device__ __forceinline__ unsigned xb_add(unsigned* p, unsigned v) { return __hip_atomic_fetch_add(p, v, __ATOMIC_RELAXED, __HIP_MEMORY_SCOPE_AGENT); }
__device__ __forceinline__ unsigned xb_xcc_id() { return (unsigned)__builtin_amdgcn_s_getreg((3 << 11) | 20) & 0xFu; }
#define XB_SPIN(cond, bar) do { unsigned _sp = 0; while (cond) { __builtin_amdgcn_s_sleep(1); \
    if ((++_sp & 255u) == 0u) { if (xb_ld(&(bar)[XB_TMO])) break; if (_sp > XB_SPIN_CAP) { atomicAdd(&(bar)[XB_TMO], 1u); break; } } } } while (0)

struct XcdBarrier {
    unsigned* bar; unsigned x;
    volatile LAS unsigned* st;
};

__device__ __forceinline__ XcdBarrier xcd_barrier_post(unsigned* bar, volatile LAS unsigned* st) {
    XcdBarrier b; b.bar = bar; b.x = xb_xcc_id(); b.st = st;
    if (threadIdx.x == 0) (void)xb_add(&bar[XB_XCNT(b.x)], 1u);
    return b;
}
__device__ __forceinline__ void xcd_barrier_complete(unsigned* bar, unsigned x, unsigned& nloc, unsigned& nx) {
    const unsigned G = gridDim.x * gridDim.y * gridDim.z;
    unsigned sum, cnt, mine, sp = 0u;
    for (;;) {
        sum = 0u; cnt = 0u; mine = 0u;
#pragma unroll
        for (unsigned j = 0; j < 16; ++j) { const unsigned c = xb_ld(&bar[XB_XCNT(j)]); sum += c; cnt += (c > 0u) ? 1u : 0u; mine = (j == x) ? c : mine; }
        if (sum == G) break;
        __builtin_amdgcn_s_sleep(1);
        if ((++sp & 255u) == 0u) { if (xb_ld(&bar[XB_TMO])) break; if (sp > XB_SPIN_CAP) { atomicAdd(&bar[XB_TMO], 1u); break; } }
    }
    nloc = mine > 0u ? mine : 1u; nx = cnt > 0u ? cnt : 1u;
}

__device__ __forceinline__ void xcd_barrier(const XcdBarrier& b) {
    asm volatile("s_waitcnt vmcnt(0)" ::: "memory");
    __syncthreads();
    if (threadIdx.x == 0) {
        unsigned* bar = b.bar;
        __builtin_amdgcn_s_waitcnt(0);
        unsigned nloc = b.st[0], nx = b.st[1];
        if (nloc == 0u) { xcd_barrier_complete(bar, b.x, nloc, nx); b.st[0] = nloc; b.st[1] = nx; }
        const unsigned old = xb_add(&bar[XB_XSUB(b.x)], 1u);
        const unsigned gen = old / nloc;
        if (old + 1u == (gen + 1u) * nloc) {
            __builtin_amdgcn_fence(__ATOMIC_RELEASE, "agent");
            asm volatile("s_waitcnt vmcnt(0)" ::: "memory");
            const unsigned og = xb_add(&bar[XB_TOP], 1u);
            const unsigned tg = og / nx;
            if (og + 1u == (tg + 1u) * nx) xb_add(&bar[XB_TOPGEN], 1u);
            else XB_SPIN(xb_ld(&bar[XB_TOPGEN]) == tg, bar);
            __builtin_amdgcn_fence(__ATOMIC_ACQUIRE, "agent");
            xb_add(&bar[XB_XGEN(b.x)], 1u);
            asm volatile("s_waitcnt vmcnt(0)" ::: "memory");
        } else {
            XB_SPIN(xb_ld(&bar[XB_XGEN(b.x)]) == gen, bar);
            __builtin_amdgcn_fence(__ATOMIC_ACQUIRE, "agent");
            asm volatile("s_waitcnt vmcnt(0)" ::: "memory");
        }
    }
    __syncthreads();
}


namespace pg8 {
#define PG8_LAS __attribute__((address_space(3)))
typedef unsigned short bf16_t;
typedef short bf16x8 __attribute__((ext_vector_type(8)));
typedef float f32x4 __attribute__((ext_vector_type(4)));
typedef unsigned u32x4 __attribute__((ext_vector_type(4)));
constexpr int BM = 256, BK = 64, HALF = 128, HTB = HALF * BK * 2  , STAGE_BYTES = 8 * HTB, NXCD = 8, WGM = 8;

__host__ __device__ __forceinline__ int lds_byte(int r, int c) { const int st = (r >> 4) * 2 + (c >> 5), rr = r & 15, cc = c & 31, ob = rr * 64 + cc * 2; return st * 1024 + (ob ^ (((ob >> 9) & 1) << 5)); }
__host__ __device__ __forceinline__ void stage_rc(int b, int& R, int& C) { const int st = b / 1024, sb = b % 1024, swz = sb ^ (((sb >> 9) & 1) << 5); R = (st >> 1) * 16 + swz / 64; C = (st & 1) * 32 + (swz % 64) / 2; }
__host__ __device__ __forceinline__ int perm32(int rho) { const int n = rho >> 4, i = rho & 15; return 8 * (i >> 2) + 4 * n + (i & 3); }

struct Unit { int pm, pn, ks; };
struct Gemm { const bf16_t* A; const bf16_t* Bt; int M, N, K; };

struct StaticOrder {
    int nM, nN, nwg, G, c;
    __host__ __device__ __forceinline__ void init(int M, int N, int G_, int c_) { nM = M / BM; nN = N / BM; nwg = nM * nN; G = G_; c = c_; }
    __host__ __device__ __forceinline__ bool next(int i, Unit& u) const {
        const long L = (long)i * G + c; if (L >= nwg) return false;
        int wgid = (int)L; { const int q = nwg / NXCD, r = nwg % NXCD, xcd = wgid % NXCD, off = wgid / NXCD; wgid = (xcd < r ? xcd * (q + 1) : r * (q + 1) + (xcd - r) * q) + off; }
        const int nig = WGM * nN, gid = wgid / nig, fm = gid * WGM, gsz = (nM - fm) < WGM ? (nM - fm) : WGM;
        u.pm = fm + ((wgid % nig) % gsz); u.pn = (wgid % nig) / gsz; u.ks = -1; return true;
    }
    __device__ __forceinline__ void a_ready(const Unit&) const {}
    __device__ __forceinline__ void done(const Unit&) const {}
    __device__ __forceinline__ int koff(const Unit&) const { return 0; }
    __device__ __forceinline__ int ntiles(const Unit&, int nt_full) const { return nt_full; }
};

typedef __bf16 bf2_t __attribute__((ext_vector_type(2)));
typedef float f2_t __attribute__((ext_vector_type(2)));
__device__ __forceinline__ unsigned cvt_pk_bf16(float lo, float hi) { const f2_t f = {lo, hi}; const bf2_t b = __builtin_convertvector(f, bf2_t); return __builtin_bit_cast(unsigned, b); }
template <class Epi, class Sched, bool ALIGN_EPI = false, bool SP2 = false>
__device__ __forceinline__ void gemm_phase(PG8_LAS unsigned char* lds, const Gemm g, const Sched& S, const Epi& E) {
    const int tid = threadIdx.x, wid = __builtin_amdgcn_readfirstlane(tid >> 6), lane = tid & 63, wr = wid >> 2, wc = wid & 3, fr = lane & 15, fq = lane >> 4;
    const int K = g.K, nt_full = K / BK;
    unsigned voffA[2], voffB[2];
#pragma unroll
    for (int i = 0; i < 2; ++i) { int R, C; stage_rc(tid * 16 + i * 8192, R, C); const int Rb = Epi::PERM ? ((R & ~31) + perm32(R & 31)) : R;
        voffA[i] = (unsigned)(R * K + C) * 2u; voffB[i] = (unsigned)(Rb * K + C) * 2u; }
    const size_t kstep = (size_t)(BK * 2);
    const size_t hstep = (size_t)HALF * K * 2;
    const size_t tstep = 2 * hstep;
    const unsigned ldsw = (unsigned)wid * 1024u;
    const int aoff = lds_byte(wr * 64 + fr, fq * 8), boff = lds_byte(wc * 32 + fr, fq * 8);
#define PG8_SA(b, h) (((b) * 2 + (h)) * HTB)
#define PG8_SB(b, h) ((4 + (b) * 2 + (h)) * HTB)
#define PG8_STAGE(bufoff, gbase, voff) do { _Pragma("unroll") for (int _i = 0; _i < 2; ++_i) \
        __builtin_amdgcn_global_load_lds((const unsigned*)((const char*)(gbase) + (voff)[_i]), (PG8_LAS unsigned*)(lds + (bufoff) + ldsw + _i * 8192), 16, 0, 0); } while (0)
#define PG8_LDA(dst, b, h) do { _Pragma("unroll") for (int m = 0; m < 4; ++m) _Pragma("unroll") for (int k = 0; k < 2; ++k) dst[m][k] = *(const PG8_LAS bf16x8*)(lds + PG8_SA(b, h) + aoff + m * 2048 + k * 1024); } while (0)
#define PG8_LDB(dst, b, h) do { _Pragma("unroll") for (int n = 0; n < 2; ++n) _Pragma("unroll") for (int k = 0; k < 2; ++k) dst[n][k] = *(const PG8_LAS bf16x8*)(lds + PG8_SB(b, h) + boff + n * 2048 + k * 1024); } while (0)
#define PG8_MMA(ai, bj, At, Bt) do { __builtin_amdgcn_s_setprio(1); _Pragma("unroll") for (int m = 0; m < 4; ++m) _Pragma("unroll") for (int n = 0; n < 2; ++n) _Pragma("unroll") for (int k = 0; k < 2; ++k) \
        acc[ai][bj][m][n] = __builtin_amdgcn_mfma_f32_16x16x32_bf16(Bt[n][k], At[m][k], acc[ai][bj][m][n], 0, 0, 0); __builtin_amdgcn_s_setprio(0); } while (0)
#define PG8_WAIT_V(n) asm volatile("s_waitcnt vmcnt(" #n ")" ::: "memory")
#define PG8_WAIT_L(n) asm volatile("s_waitcnt lgkmcnt(" #n ")" ::: "memory")
#define PG8_BAR __builtin_amdgcn_s_barrier()
#define PG8_SCHED __builtin_amdgcn_sched_barrier(0)
    Unit cur, nxt; int ui = 0;
    if (!S.next(0, cur)) return;
    f32x4 acc[2][2][4][2];
#pragma unroll
    for (int a = 0; a < 2; ++a)
#pragma unroll
        for (int b = 0; b < 2; ++b)
#pragma unroll
            for (int m = 0; m < 4; ++m)
#pragma unroll
                for (int n = 0; n < 2; ++n) acc[a][b][m][n] = (f32x4){0.f, 0.f, 0.f, 0.f};
    bf16x8 At[4][2], B0[2][2], B1[2][2];
    const char* cA = (const char*)g.A + (size_t)cur.pm * tstep + (size_t)S.koff(cur) * 2; const char* cB = (const char*)g.Bt + (size_t)cur.pn * tstep + (size_t)S.koff(cur) * 2;
    S.a_ready(cur);
    if constexpr (SP2) {
        PG8_STAGE(PG8_SB(0, 0), cB, voffB); PG8_STAGE(PG8_SB(0, 1), cB + hstep, voffB); PG8_STAGE(PG8_SA(0, 0), cA, voffA); PG8_STAGE(PG8_SA(0, 1), cA + hstep, voffA);
        if (wr == 1) PG8_BAR;
        PG8_WAIT_V(2); PG8_BAR;
        PG8_STAGE(PG8_SB(1, 0), cB + kstep, voffB); PG8_STAGE(PG8_SA(1, 0), cA + kstep, voffA); PG8_STAGE(PG8_SB(1, 1), cB + hstep + kstep, voffB);
        PG8_WAIT_V(6); PG8_BAR;
    } else {
        PG8_STAGE(PG8_SB(0, 0), cB, voffB); PG8_STAGE(PG8_SA(0, 0), cA, voffA); PG8_STAGE(PG8_SB(0, 1), cB + hstep, voffB); PG8_STAGE(PG8_SA(0, 1), cA + hstep, voffA);
        if (wr == 1) PG8_BAR;
        PG8_WAIT_V(4); PG8_BAR;
        PG8_STAGE(PG8_SB(1, 0), cB + kstep, voffB); PG8_STAGE(PG8_SA(1, 0), cA + kstep, voffA); PG8_STAGE(PG8_SB(1, 1), cB + hstep + kstep, voffB);
        PG8_WAIT_V(6); PG8_BAR;
    }
    for (;;) {
        const bool has_next = S.next(ui + 1, nxt);
        const char* nA = has_next ? (const char*)g.A + (size_t)nxt.pm * tstep + (size_t)S.koff(nxt) * 2 : cA; const char* nB = has_next ? (const char*)g.Bt + (size_t)nxt.pn * tstep + (size_t)S.koff(nxt) * 2 : cB;
        const int nt = S.ntiles(cur, nt_full);
        for (int t = 0; t < nt; t += 2) {
            const bool last = (t == nt - 2);
            const char* a1 = cA + (size_t)(t + 1) * kstep;
            const char* a2 = last ? nA : cA + (size_t)(t + 2) * kstep; const char* b2 = last ? nB : cB + (size_t)(t + 2) * kstep;
            const char* a3 = a2 + kstep; const char* b3 = b2 + kstep;
            if (last && has_next) S.a_ready(nxt);
            if constexpr (SP2) {
            PG8_LDB(B0, 0, 0); PG8_LDB(B1, 0, 1); PG8_SCHED; PG8_LDA(At, 0, 0); PG8_STAGE(PG8_SA(1, 1), a1 + hstep, voffA);
            PG8_WAIT_V(8); PG8_WAIT_L(0); PG8_BAR; PG8_MMA(0, 0, At, B0); PG8_MMA(0, 1, At, B1); PG8_BAR; PG8_SCHED;
            PG8_LDA(At, 0, 1); PG8_STAGE(PG8_SB(0, 0), b2, voffB); PG8_STAGE(PG8_SB(0, 1), b2 + hstep, voffB); PG8_STAGE(PG8_SA(0, 0), a2, voffA);
            PG8_WAIT_V(8); PG8_WAIT_L(0); PG8_BAR; PG8_MMA(1, 0, At, B0); PG8_MMA(1, 1, At, B1); PG8_BAR; PG8_SCHED;
            PG8_LDB(B0, 1, 0); PG8_LDB(B1, 1, 1); PG8_SCHED; PG8_LDA(At, 1, 0); PG8_STAGE(PG8_SA(0, 1), a2 + hstep, voffA);
            PG8_WAIT_V(8); PG8_WAIT_L(0); PG8_BAR; PG8_MMA(0, 0, At, B0); PG8_MMA(0, 1, At, B1); PG8_BAR; PG8_SCHED;
            PG8_LDA(At, 1, 1); PG8_STAGE(PG8_SB(1, 0), b3, voffB); PG8_STAGE(PG8_SB(1, 1), b3 + hstep, voffB); PG8_STAGE(PG8_SA(1, 0), a3, voffA);
            PG8_WAIT_V(8); PG8_WAIT_L(0); PG8_BAR; PG8_MMA(1, 0, At, B0); PG8_MMA(1, 1, At, B1); PG8_BAR; PG8_SCHED;
            } else {
            PG8_LDB(B0, 0, 0); PG8_SCHED; PG8_LDA(At, 0, 0); PG8_STAGE(PG8_SA(1, 1), a1 + hstep, voffA);
            PG8_WAIT_L(8); PG8_BAR; PG8_WAIT_L(0); PG8_MMA(0, 0, At, B0); PG8_BAR; PG8_SCHED;
            PG8_LDB(B1, 0, 1); PG8_STAGE(PG8_SB(0, 0), b2, voffB);
            PG8_BAR; PG8_WAIT_L(0); PG8_MMA(0, 1, At, B1); PG8_BAR;
            PG8_LDA(At, 0, 1); PG8_STAGE(PG8_SA(0, 0), a2, voffA);
            PG8_BAR; PG8_WAIT_L(0); PG8_MMA(1, 0, At, B0); PG8_BAR; PG8_SCHED;
            PG8_STAGE(PG8_SB(0, 1), b2 + hstep, voffB);
            PG8_WAIT_V(6); PG8_BAR; PG8_MMA(1, 1, At, B1); PG8_BAR;
            PG8_LDB(B0, 1, 0); PG8_SCHED; PG8_LDA(At, 1, 0); PG8_STAGE(PG8_SA(0, 1), a2 + hstep, voffA);
            PG8_WAIT_L(8); PG8_BAR; PG8_WAIT_L(0); PG8_MMA(0, 0, At, B0); PG8_BAR; PG8_SCHED;
            PG8_LDB(B1, 1, 1); PG8_STAGE(PG8_SB(1, 0), b3, voffB);
            PG8_BAR; PG8_WAIT_L(0); PG8_MMA(0, 1, At, B1); PG8_BAR;
            PG8_LDA(At, 1, 1); PG8_STAGE(PG8_SA(1, 0), a3, voffA);
            PG8_BAR; PG8_WAIT_L(0); PG8_MMA(1, 0, At, B0); PG8_BAR; PG8_SCHED;
            PG8_STAGE(PG8_SB(1, 1), b3 + hstep, voffB);
            PG8_WAIT_V(6); PG8_BAR; PG8_MMA(1, 1, At, B1); PG8_BAR;
            }
        }
        if constexpr (ALIGN_EPI) { if (wr == 0) PG8_BAR; }
        if constexpr (!Epi::AFTER_DRAIN) { E(acc, cur, wr, wc, fr, fq); S.done(cur); }
        if (!has_next) break;
#pragma unroll
        for (int a = 0; a < 2; ++a)
#pragma unroll
            for (int b = 0; b < 2; ++b)
#pragma unroll
                for (int m = 0; m < 4; ++m)
#pragma unroll
                    for (int n = 0; n < 2; ++n) acc[a][b][m][n] = (f32x4){0.f, 0.f, 0.f, 0.f};
        cur = nxt; cA = nA; cB = nB; ++ui;
        if constexpr (ALIGN_EPI) { if (wr == 1) PG8_BAR; }
    }
    PG8_WAIT_V(0);
    if constexpr (!ALIGN_EPI) { if (wr == 0) PG8_BAR; }
    PG8_BAR;
    if constexpr (Epi::AFTER_DRAIN) { E.fused(acc, cur, wr, wc, fr, fq, lds, wid, lane); S.done(cur); }
#undef PG8_SA
#undef PG8_SB
#undef PG8_STAGE
#undef PG8_LDA
#undef PG8_LDB
#undef PG8_MMA
#undef PG8_WAIT_V
#undef PG8_WAIT_L
#undef PG8_BAR
#undef PG8_SCHED
}
}

using pg8::Unit; using pg8::Gemm;
typedef unsigned u32x4 __attribute__((ext_vector_type(4)));
typedef unsigned u32x2 __attribute__((ext_vector_type(2)));
DI float fsig(float v) { return __builtin_amdgcn_rcpf(1.f + __expf(-v)); }
DI f32x4 unpack4(u32x2 g) { return (f32x4){__uint_as_float(g.x << 16), __uint_as_float(g.x & 0xffff0000u), __uint_as_float(g.y << 16), __uint_as_float(g.y & 0xffff0000u)}; }

struct RectOrder : pg8::StaticOrder {
    int xM, xN, xwg;
    DI void init2(int M, int N, int G_, int c_, int xM_, int xN_) { init(M, N, G_, c_); xM = xM_; xN = xN_; xwg = xM_ * xN_; }
    DI bool next(int i, Unit& u) const {
        const long Lx = (long)i * G + c;
        if (Lx < nwg) return pg8::StaticOrder::next(i, u);
        if (Lx >= nwg + xwg) return false;
        const int l2 = (int)(Lx - nwg); u.pm = nM + l2 % xM; u.pn = l2 / xM; u.ks = -1; return true;
    }
};
struct SplitOrder : pg8::StaticOrder {
    int xM, xwg, kq;
    DI void init2(int M, int N, int G_, int c_, int xM_, int K) { init(M, N, G_, c_); xM = xM_; xwg = xM_ * nN * 4; kq = K / 4; }
    DI bool next(int i, Unit& u) const {
        const long Lx = (long)i * G + c;
        if (Lx < nwg) return pg8::StaticOrder::next(i, u);
        if (Lx >= nwg + xwg) return false;
        const int l2 = (int)(Lx - nwg), sl = l2 & 3, tile = l2 >> 2; u.pm = nM + tile % xM; u.pn = tile / xM; u.ks = sl; return true;
    }
    DI int koff(const Unit& u) const { return u.ks < 0 ? 0 : u.ks * kq; }
    DI int ntiles(const Unit& u, int nt_full) const { return u.ks < 0 ? nt_full : kq / 64; }
};
template <bool SPLIT> struct MoeOrderT : SplitOrder {
    const LAS unsigned char* pe;
    DI bool next(int i, Unit& u) const { if (SPLIT ? !SplitOrder::next(i, u) : !pg8::StaticOrder::next(i, u)) return false; u.pn += (int)pe[u.pm] * nN; return true; }
};
typedef MoeOrderT<false> MoeOrder;

struct EpiInproj {
    static constexpr bool PERM = true, AFTER_DRAIN = false;
    bf16_t* P;
    DI void operator()(const f32x4 (&acc)[2][2][4][2], const Unit& u, int wr, int wc, int fr, int fq) const {
        const int pn = u.pn, row0 = u.pm * 256 + wr * 64 + fr;
        if (pn >= 32 && pn < 48) {
            const int col = PU + 128 * (pn - 32) + wc * 32 + 8 * fq;
#pragma unroll
            for (int ai = 0; ai < 2; ++ai)
#pragma unroll
                for (int m = 0; m < 4; ++m) { const f32x4 v0 = acc[ai][0][m][0] * acc[ai][1][m][0], v1 = acc[ai][0][m][1] * acc[ai][1][m][1];
                    u32x4 o; o.x = pg8::cvt_pk_bf16(v0[0], v0[1]); o.y = pg8::cvt_pk_bf16(v0[2], v0[3]); o.z = pg8::cvt_pk_bf16(v1[0], v1[1]); o.w = pg8::cvt_pk_bf16(v1[2], v1[3]);
                    *(u32x4*)(P + (size_t)(row0 + ai * 128 + m * 16) * LDP + col) = o; }
        } else {
            const int col = (pn < 32 ? 256 * pn : 256 * (pn - 8)) + wc * 32 + 8 * fq;
            const int act = (pn >= 16 && pn < 24) ? 1 : (pn >= 48 ? 2 : 0);
#pragma unroll
            for (int ai = 0; ai < 2; ++ai)
#pragma unroll
                for (int m = 0; m < 4; ++m)
#pragma unroll
                    for (int bj = 0; bj < 2; ++bj) { f32x4 v0 = acc[ai][bj][m][0], v1 = acc[ai][bj][m][1];
                        if (act) {
#pragma unroll
                            for (int j = 0; j < 4; ++j) { const float s0 = fsig(v0[j]), s1 = fsig(v1[j]); v0[j] = act == 1 ? v0[j] * s0 : s0; v1[j] = act == 1 ? v1[j] * s1 : s1; } }
                        u32x4 o; o.x = pg8::cvt_pk_bf16(v0[0], v0[1]); o.y = pg8::cvt_pk_bf16(v0[2], v0[3]); o.z = pg8::cvt_pk_bf16(v1[0], v1[1]); o.w = pg8::cvt_pk_bf16(v1[2], v1[3]);
                        *(u32x4*)(P + (size_t)(row0 + ai * 128 + m * 16) * LDP + col + bj * 128) = o; }
        }
    }
};
DI u32x4 pack8(const f32x4 v0, const f32x4 v1) { u32x4 o; o.x = pg8::cvt_pk_bf16(v0[0], v0[1]); o.y = pg8::cvt_pk_bf16(v0[2], v0[3]); o.z = pg8::cvt_pk_bf16(v1[0], v1[1]); o.w = pg8::cvt_pk_bf16(v1[2], v1[3]); return o; }
struct EpiGateA {
    static constexpr bool PERM = true, AFTER_DRAIN = false;
    bf16_t* out; const bf16_t* P; int gcol; float* part; int row0p, prows;
    DI void operator()(const f32x4 (&acc)[2][2][4][2], const Unit& u, int wr, int wc, int fr, int fq) const {
        const int row0 = u.pm * 256 + wr * 64 + fr, col0 = u.pn * 256 + wc * 32 + 8 * fq;
#pragma unroll
        for (int ai = 0; ai < 2; ++ai)
#pragma unroll
            for (int m = 0; m < 4; ++m) { const size_t r = (size_t)(row0 + ai * 128 + m * 16);
#pragma unroll
                for (int bj = 0; bj < 2; ++bj) { const int c = col0 + bj * 128; const u32x4 gq = *(const u32x4*)(P + r * LDP + gcol + c);
                    const f32x4 v0 = acc[ai][bj][m][0] * unpack4((u32x2){gq.x, gq.y}), v1 = acc[ai][bj][m][1] * unpack4((u32x2){gq.z, gq.w});
                    if (u.ks < 0) *(u32x4*)(out + r * D + c) = pack8(v0, v1);
                    else { float* rp = part + ((size_t)u.ks * prows + (r - row0p)) * D + c; *(f32x4*)rp = v0; *(f32x4*)(rp + 4) = v1; } } }
    }
};
struct EpiGateB {
    static constexpr bool PERM = true, AFTER_DRAIN = false;
    bf16_t* out; const bf16_t* ma; const bf16_t* P; int gcol; float* part; int row0p, prows;
    DI void operator()(const f32x4 (&acc)[2][2][4][2], const Unit& u, int wr, int wc, int fr, int fq) const {
        const int row0 = u.pm * 256 + wr * 64 + fr, col0 = u.pn * 256 + wc * 32 + 8 * fq;
#pragma unroll
        for (int ai = 0; ai < 2; ++ai)
#pragma unroll
            for (int m = 0; m < 4; ++m) { const size_t r = (size_t)(row0 + ai * 128 + m * 16);
#pragma unroll
                for (int bj = 0; bj < 2; ++bj) { const int c = col0 + bj * 128;
                    const u32x4 gq = *(const u32x4*)(P + r * LDP + gcol + c);
                    const f32x4 g0 = acc[ai][bj][m][0] * unpack4((u32x2){gq.x, gq.y}), g1 = acc[ai][bj][m][1] * unpack4((u32x2){gq.z, gq.w});
                    if (u.ks < 0) { const u32x4 aq = *(const u32x4*)(ma + r * D + c);
                        *(u32x4*)(out + r * D + c) = pack8(unpack4((u32x2){aq.x, aq.y}) + g0, unpack4((u32x2){aq.z, aq.w}) + g1); }
                    else { float* rp = part + ((size_t)u.ks * prows + (r - row0p)) * D + c; *(f32x4*)rp = g0; *(f32x4*)(rp + 4) = g1; } } }
    }
};
struct EpiF32 {
    static constexpr bool PERM = true, AFTER_DRAIN = false;
    bf16_t* out; float* part; int row0p, prows;
    DI void operator()(const f32x4 (&acc)[2][2][4][2], const Unit& u, int wr, int wc, int fr, int fq) const {
        const int row0 = u.pm * 256 + wr * 64 + fr, col0 = (u.pn & 7) * 256 + wc * 32 + 8 * fq;
        if (u.ks < 0) {
#pragma unroll
            for (int ai = 0; ai < 2; ++ai)
#pragma unroll
                for (int m = 0; m < 4; ++m)
#pragma unroll
                    for (int bj = 0; bj < 2; ++bj) *(u32x4*)(out + (size_t)(row0 + ai * 128 + m * 16) * D + col0 + bj * 128) = pack8(acc[ai][bj][m][0], acc[ai][bj][m][1]);
        } else {
            float* base = part + ((size_t)u.ks * prows + (row0 - row0p)) * D + col0;
#pragma unroll
            for (int ai = 0; ai < 2; ++ai)
#pragma unroll
                for (int m = 0; m < 4; ++m)
#pragma unroll
                    for (int bj = 0; bj < 2; ++bj) { float* rp = base + (size_t)(ai * 128 + m * 16) * D + bj * 128; *(f32x4*)rp = acc[ai][bj][m][0]; *(f32x4*)(rp + 4) = acc[ai][bj][m][1]; }
        }
    }
};
struct EpiSwiglu {
    static constexpr bool PERM = true, AFTER_DRAIN = false;
    bf16_t* out;
    DI void operator()(const f32x4 (&acc)[2][2][4][2], const Unit& u, int wr, int wc, int fr, int fq) const {
        const int row0 = u.pm * 256 + wr * 64 + fr, col = (u.pn % 44) * 128 + wc * 32 + 8 * fq;
#pragma unroll
        for (int ai = 0; ai < 2; ++ai)
#pragma unroll
            for (int m = 0; m < 4; ++m) { f32x4 v0, v1;
#pragma unroll
                for (int j = 0; j < 4; ++j) { const float a0 = acc[ai][0][m][0][j], a1 = acc[ai][0][m][1][j]; v0[j] = a0 * fsig(a0) * acc[ai][1][m][0][j]; v1[j] = a1 * fsig(a1) * acc[ai][1][m][1][j]; }
                u32x4 o; o.x = pg8::cvt_pk_bf16(v0[0], v0[1]); o.y = pg8::cvt_pk_bf16(v0[2], v0[3]); o.z = pg8::cvt_pk_bf16(v1[0], v1[1]); o.w = pg8::cvt_pk_bf16(v1[2], v1[3]);
                *(u32x4*)(out + (size_t)(row0 + ai * 128 + m * 16) * DFF + col) = o; }
    }
};

DI void conv_tile(const float* __restrict__ src, int ld, bf16_t* __restrict__ dst, int K, int k0, float scale, float* tile  ) {
    const int tid = threadIdx.x;
    __syncthreads();
#pragma unroll
    for (int ps = 0; ps < 4; ++ps) { const int kr = ps * 32 + (tid >> 4), c4 = (tid & 15) * 4;
        const float4 v = *(const float4*)(src + (size_t)(k0 + kr) * ld + c4);
        float* t = tile + kr * 65 + c4; t[0] = v.x; t[1] = v.y; t[2] = v.z; t[3] = v.w; }
    __syncthreads();
#pragma unroll
    for (int ps = 0; ps < 2; ++ps) { const int n = ps * 32 + (tid >> 4), kc = (tid & 15) * 8; const float* t = tile + kc * 65 + n;
        u32x4 o; o.x = pg8::cvt_pk_bf16(t[0] * scale, t[65] * scale); o.y = pg8::cvt_pk_bf16(t[130] * scale, t[195] * scale);
        o.z = pg8::cvt_pk_bf16(t[260] * scale, t[325] * scale); o.w = pg8::cvt_pk_bf16(t[390] * scale, t[455] * scale);
        *(u32x4*)(dst + (size_t)n * K + k0 + kc) = o; }
}
DI int win_src_col(int vn) {
    if (vn < 4096) return vn;
    if (vn < 6144) return OFF_R + vn - 4096;
    if (vn < 8192) return OFF_CB + vn - 6144;
    if (vn < 12288) { const int t = (vn - 8192) >> 8, wi = (vn - 8192) & 255; return wi < 128 ? OFF_CC + 128 * t + wi : OFF_CX + 128 * t + wi - 128; }
    if (vn < 14336) return OFF_GA + vn - 12288;
    return OFF_GB + vn - 14336;
}
struct CT { const float* src; bf16_t* dst; int ld, K, k0; float scale; };
constexpr int DT_D0 = 0, DT_D1 = DT_D0 + 1536, DT_D1B = DT_D1 + 2816, DT_D2 = DT_D1B + 1408, DT_D2B = DT_D2 + 4096, DT_D2C = DT_D2B + 16, DT_D3 = DT_D2C + 1536, DT_D3B = DT_D3 + 8 * 2816, DT_END = DT_D3B + 8 * 1408;
DI CT conv_sq(const Params& p, unsigned char* ws, int l, int u) {
    const int kt = u & 15, g = (u >> 4) & 31, which = u >> 9;
    const float* src = (which == 0 ? p.w_proj_a : which == 1 ? p.w_proj_b : p.w_out) + (size_t)l * D * D + g * 64;
    bf16_t* dst = (bf16_t*)(ws + (which == 0 ? WS_WA : which == 1 ? WS_WB : WS_WO)) + ((size_t)l * D + g * 64) * D;
    return CT{src, dst, D, D, kt * 128, 1.f};
}
DI CT conv_up(const Params& p, unsigned char* ws, int e, int u) {
    const int kt = u & 15, g = u >> 4, t = (g * 64) >> 8, wi = (g * 64) & 255;
    const float* w1 = e == 8 ? p.ffn_w1 : p.moe_w1 + (size_t)e * D * DFF; const float* w3 = e == 8 ? p.ffn_w3 : p.moe_w3 + (size_t)e * D * DFF;
    const float* src = wi < 128 ? w1 + 128 * t + wi : w3 + 128 * t + wi - 128;
    bf16_t* dst = (e == 8 ? (bf16_t*)(ws + WS_F1) : (bf16_t*)(ws + WS_M1) + (size_t)e * 11264 * D) + (size_t)g * 64 * D;
    return CT{src, dst, DFF, D, kt * 128, 1.f};
}
DI CT conv_down(const Params& p, unsigned char* ws, int e, int u) {
    const int kt = u % 44, g = u / 44;
    const float* src = (e == 8 ? p.ffn_w2 : p.moe_w2 + (size_t)e * DFF * D) + g * 64;
    bf16_t* dst = (e == 8 ? (bf16_t*)(ws + WS_F2) : (bf16_t*)(ws + WS_M2) + (size_t)e * D * DFF) + (size_t)g * 64 * DFF;
    return CT{src, dst, D, DFF, kt * 128, 1.f};
}
DI CT conv_win(const Params& p, unsigned char* ws, int l, int u) {
    const int kt = u & 15, g = u >> 4;
    return CT{p.w_in + (size_t)l * D * NIN + win_src_col(g * 64), (bf16_t*)(ws + WS_WIN) + ((size_t)l * 16384 + g * 64) * D, NIN, D, kt * 128, g < 16 ? 0.0625f : 1.f};
}
DI CT conv_wg(const Params& p, unsigned char* ws, int l, int u) { return CT{p.w_in + (size_t)l * D * NIN + OFF_AF, (bf16_t*)(ws + WS_WG) + (size_t)l * 64 * D, NIN, D, (u & 15) * 128, 1.f}; }
DI CT conv_deferred(const Params& p, unsigned char* ws, int i) {
    if (i < DT_D1) return conv_sq(p, ws, 0, i - DT_D0);
    if (i < DT_D1B) return conv_up(p, ws, 8, i - DT_D1);
    if (i < DT_D2) return conv_down(p, ws, 8, i - DT_D1B);
    if (i < DT_D2B) return conv_win(p, ws, 1, i - DT_D2);
    if (i < DT_D2C) return conv_wg(p, ws, 1, i - DT_D2B);
    if (i < DT_D3) return conv_sq(p, ws, 1, i - DT_D2C);
    if (i < DT_D3B) { const int u = i - DT_D3; return conv_up(p, ws, u / 2816, u % 2816); }
    const int u = i - DT_D3B; return conv_down(p, ws, u / 1408, u % 1408);
}
struct CReg { float4 v[4]; };
DI void conv_load(const CT& c, CReg& r) { const int tid = threadIdx.x;
#pragma unroll
    for (int ps = 0; ps < 4; ++ps) { const f32x4 t = __builtin_nontemporal_load((const f32x4*)(c.src + (size_t)(c.k0 + ps * 32 + (tid >> 4)) * c.ld + (tid & 15) * 4)); r.v[ps] = make_float4(t[0], t[1], t[2], t[3]); } }
DI void conv_to_lds(const CReg& r, float* tile) { const int tid = threadIdx.x;
#pragma unroll
    for (int ps = 0; ps < 4; ++ps) { float* t = tile + (ps * 32 + (tid >> 4)) * 65 + (tid & 15) * 4; t[0] = r.v[ps].x; t[1] = r.v[ps].y; t[2] = r.v[ps].z; t[3] = r.v[ps].w; } }
DI void conv_out(const CT& c, const float* tile) { const int tid = threadIdx.x;
#pragma unroll
    for (int ps = 0; ps < 2; ++ps) { const int n = ps * 32 + (tid >> 4), kc = (tid & 15) * 8; const float* t = tile + kc * 65 + n; const float sc = c.scale;
        u32x4 o; o.x = pg8::cvt_pk_bf16(t[0] * sc, t[65] * sc); o.y = pg8::cvt_pk_bf16(t[130] * sc, t[195] * sc); o.z = pg8::cvt_pk_bf16(t[260] * sc, t[325] * sc); o.w = pg8::cvt_pk_bf16(t[390] * sc, t[455] * sc);
        *(u32x4*)(c.dst + (size_t)n * c.K + c.k0 + kc) = o; } }
template <class F> DI void conv_stream(F desc, int begin, int end, int rank, int nshare, unsigned char* ldsb) {
    float* t0 = (float*)ldsb; float* t1 = t0 + 128 * 65;
    const int first = begin + rank; if (first >= end) return;
    const int n = (end - first + nshare - 1) / nshare;
    auto idx = [&](int j) { return first + (j < n ? j : n - 1) * nshare; };
#ifndef CONVREP
#define CONVREP 1
#endif
    for (int crep = 0; crep < CONVREP; ++crep) {
    CReg ra, rb; CT ca = desc(idx(0)), cb = desc(idx(1)); conv_load(ca, ra); conv_load(cb, rb);
    __syncthreads();
#pragma unroll 1
    for (int j = 0; j < n; j += 2) {
        conv_to_lds(ra, t0); const CT oa = ca; ca = desc(idx(j + 2)); conv_load(ca, ra);
        __syncthreads();
        conv_out(oa, t0);
        conv_to_lds(rb, t1); const CT ob = cb; cb = desc(idx(j + 3)); conv_load(cb, rb);
        __syncthreads();
        if (j + 1 < n) conv_out(ob, t1);
    }
    __syncthreads();
    }
}
DI void ph_convert(const Params& p, unsigned char* ws, int bid, int nblk, unsigned char* ldsb) {
    conv_stream([&](int i) { return i < 4096 ? conv_win(p, ws, 0, i) : conv_wg(p, ws, 0, i - 4096); }, 0, 4096 + 16, bid, nblk, ldsb);
}
#ifndef SLOT_T58
#define SLOT_T58 28
#endif
#ifndef SLOT_G2
#define SLOT_G2 116
#endif
#ifndef SLOT_G1
#define SLOT_G1 7
#endif
constexpr int NSLOT = 10;
constexpr int SLOT_N[NSLOT] = {192 * SLOT_G1, 128 * SLOT_G2, 128 * (SLOT_T58 * 14 / 58), 128 * (SLOT_T58 * 14 / 58), 128 * (SLOT_T58 * 14 / 58), 208 * SLOT_T58, 128 * (SLOT_T58 * 33 / 58), 192 * SLOT_T58, 192 * SLOT_G1, 128 * SLOT_G2};
constexpr int slot_begin(int s) { int b = 0; for (int i = 0; i < s; ++i) b += SLOT_N[i]; return b < DT_END ? b : DT_END; }
static_assert(slot_begin(2) >= DT_D1, "w_proj_a/b, w_out of layer 0 must be converted before proj-a L0");
static_assert(slot_begin(5) >= DT_D2, "the dense FFN weights must be converted before FFN-up L0");
static_assert(slot_begin(7) >= DT_D3, "layer-1 in-projection / projection weights must be converted before in-proj L1");
DI void conv_slot(const Params& p, int s_begin, int s_end, int total, int bid, int nblk, unsigned char* ldsb) {
    if (!(FAST & FB_CONV) || s_begin >= s_end) return;
    const int rem = total % nblk;
    int rank, nshare; if (rem == 0) { rank = bid; nshare = nblk; } else { if (bid < rem) return; rank = bid - rem; nshare = nblk - rem; }
    conv_stream([&](int i) { return conv_deferred(p, p.ws, i); }, s_begin, s_end, rank, nshare, ldsb);
}
DI void conv_slot_direct(const Params& p, int s_begin, int s_end, int rank, int nshare, unsigned char* ldsb) {
    if (!(FAST & FB_CONV) || s_begin >= s_end || nshare <= 0) return;
    conv_stream([&](int i) { return conv_deferred(p, p.ws, i); }, s_begin, s_end, rank, nshare, ldsb);
}
#define CONV_SLOT(s, total) conv_slot(p, slot_begin(s), slot_begin((s) + 1), (total), bid, nblk, lds)

template <int L> DI void ph_gate_fast(const Ws& w, int bid, int nblk) {
    const int lane = threadIdx.x & 63, wave = threadIdx.x >> 6, fr = lane & 15, fq = lane >> 4;
    const bf16_t* wg = (const bf16_t*)(w.b + WS_WG) + (size_t)L * 64 * D;
    for (int t = wave * nblk + bid; t < MT / 16; t += 8 * nblk) {
        f32x4 a0 = {0.f, 0.f, 0.f, 0.f}, a1 = {0.f, 0.f, 0.f, 0.f};
        const bf16_t* ap = w.h_() + (size_t)(t * 16 + fr) * D + fq * 8; const bf16_t* bp0 = wg + (size_t)fr * D + fq * 8; const bf16_t* bp1 = bp0 + 16 * D;
#pragma unroll 8
        for (int k0 = 0; k0 < D; k0 += 32) { const pg8::bf16x8 a = *(const pg8::bf16x8*)(ap + k0), b0 = *(const pg8::bf16x8*)(bp0 + k0), b1 = *(const pg8::bf16x8*)(bp1 + k0);
            a0 = __builtin_amdgcn_mfma_f32_16x16x32_bf16(a, b0, a0, 0, 0, 0); a1 = __builtin_amdgcn_mfma_f32_16x16x32_bf16(a, b1, a1, 0, 0, 0); }
#pragma unroll
        for (int j = 0; j < 4; ++j) { float* o = w.pg_() + (size_t)(t * 16 + 4 * fq + j) * 32; o[fr] = a0[j]; o[16 + fr] = a1[j]; }
    }
}

#define GLDS(lds) ((LAS unsigned char*)(lds))
template <int L> DI void ph_inproj_fast(const Params& p, const Ws& w, int bid, int nblk, unsigned char* lds) {
    Gemm g{w.h_(), (const bf16_t*)(w.b + WS_WIN) + (size_t)L * 16384 * D, MT, 16384, D};
    RectOrder S; if (L == 0) S.init2(MT, 16384, nblk, bid, 0, 0); else S.init2(ML, 16384, nblk, bid, MC / 256, 16);
    EpiInproj E{w.P_()};
    pg8::gemm_phase<EpiInproj, RectOrder, true, true>(GLDS(lds), g, S, E);
    ph_gate_fast<L>(w, bid, nblk);
    if (L == 1) CONV_SLOT(7, 2048 + 64);
}
template <int L> DI void ph_pa_fast(const Params& p, const Ws& w, int bid, int nblk, unsigned char* lds) {
    Gemm g{w.ya_(), (const bf16_t*)(w.b + WS_WA) + (size_t)L * D * D, L == 0 ? MT : ML, D, D}; SplitOrder S; S.init2(ML, D, nblk, bid, L == 0 ? MC / 256 : 0, D);
    EpiGateA E{w.ma_(), w.P_(), PGA, (float*)(w.b + WS_MMP), ML, MC};
    pg8::gemm_phase<EpiGateA, SplitOrder, true, true>(GLDS(lds), g, S, E);
    if (L == 0) CONV_SLOT(2, 256 + 128);
}
template <int L> DI void ph_pb_fast(const Params& p, const Ws& w, int bid, int nblk, unsigned char* lds) {
    Gemm g{w.obr_(), (const bf16_t*)(w.b + WS_WB) + (size_t)L * D * D, L == 0 ? MT : ML, D, D}; SplitOrder S; S.init2(ML, D, nblk, bid, L == 0 ? MC / 256 : 0, D);
    EpiGateB E{w.mrg_(), w.ma_(), w.P_(), PGB, (float*)(w.b + WS_YSP), ML, MC};
    pg8::gemm_phase<EpiGateB, SplitOrder, true, true>(GLDS(lds), g, S, E);
    if (L == 0) CONV_SLOT(3, 256 + 128);
}
DI void ph_mrg_ctx(const Ws& w, int bid, int nblk) {
    const int lane = threadIdx.x & 63, gw = bid * 8 + (threadIdx.x >> 6), nw = nblk * 8;
    for (int r = gw; r < MC; r += nw) {
        float a[4][8], b[4][8];
        ld_row_part4((const float*)(w.b + WS_MMP) + (size_t)r * D, (size_t)MC * D, lane, a);
        ld_row_part4((const float*)(w.b + WS_YSP) + (size_t)r * D, (size_t)MC * D, lane, b);
#pragma unroll
        for (int j = 0; j < 4; ++j)
#pragma unroll
            for (int i = 0; i < 8; ++i) a[j][i] += b[j][i];
        st_row_bf16(w.mrg_() + (size_t)(ML + r) * D, lane, a);
    }
}
template <int L> DI void ph_wo_fast(const Params& p, const Ws& w, int bid, int nblk, unsigned char* lds) {
    Gemm g{w.mrg_(), (const bf16_t*)(w.b + WS_WO) + (size_t)L * D * D, L == 0 ? MT : ML, D, D};
    SplitOrder S; S.init2(ML, D, nblk, bid, L == 0 ? MC / 256 : 0, D);
    EpiF32 E{w.mm_(), (float*)(w.b + WS_MMP), ML, MC};
    pg8::gemm_phase<EpiF32, SplitOrder, true, true>(GLDS(lds), g, S, E);
    if (L == 0) CONV_SLOT(4, 256 + 128);
}
DI const LAS unsigned char* moe_panel_table(const Ws& w, unsigned char* lds, int& npanels) {
    int off[9]; moe_offsets(w, off); npanels = off[8] >> 8;
    LAS unsigned char* pe = (LAS unsigned char*)(lds + 131072 + 1024);
    __syncthreads();
    if (threadIdx.x < 80) { const int m0 = (int)threadIdx.x * 256; pe[threadIdx.x] = (unsigned char)expert_of_row(off, m0); }
    __syncthreads();
    return pe;
}
template <int L> DI void ph_f1_fast(const Params& p, const Ws& w, int bid, int nblk, unsigned char* lds) {
    if (L == 0) {
        Gemm g{w.h_(), (const bf16_t*)(w.b + WS_F1), MT, 11264, D}; pg8::StaticOrder S; S.init(MT, 11264, nblk, bid);
        EpiSwiglu E{w.gg_()};
        pg8::gemm_phase<EpiSwiglu, pg8::StaticOrder, true, true>(GLDS(lds), g, S, E);
        CONV_SLOT(5, 36 * 44);
    } else {
        int np; const LAS unsigned char* pe = moe_panel_table(w, lds, np);
        Gemm g{w.hs_(), (const bf16_t*)(w.b + WS_M1), np * 256, 11264, D}; MoeOrder S; S.init(np * 256, 11264, nblk, bid); S.pe = pe;
        EpiSwiglu E{w.gg_()};
        pg8::gemm_phase<EpiSwiglu, MoeOrder, true, true>(GLDS(lds), g, S, E);
    }
}
template <int L> DI void ph_f2_fast(const Params& p, const Ws& w, int bid, int nblk, unsigned char* lds) {
    if (L == 0) {
        Gemm g{w.gg_(), (const bf16_t*)(w.b + WS_F2), MT, D, DFF}; SplitOrder S; S.init2(ML, D, nblk, bid, MC / 256, DFF);
        EpiF32 E{w.mm_(), (float*)(w.b + WS_MMP), ML, MC};
        pg8::gemm_phase<EpiF32, SplitOrder, true, true>(GLDS(lds), g, S, E);
        CONV_SLOT(6, 256 + 128);
    } else {
        int np; const LAS unsigned char* pe = moe_panel_table(w, lds, np);
        Gemm g{w.gg_(), (const bf16_t*)(w.b + WS_M2), np * 256, D, DFF}; MoeOrderT<true> S; S.init2(64 * 256, D, nblk, bid, np - 64, DFF); S.pe = pe;
        EpiF32 E{w.ys_(), (float*)(w.b + WS_YSP), 64 * 256, 2048};
        pg8::gemm_phase<EpiF32, MoeOrderT<true>, true, true>(GLDS(lds), g, S, E);
    }
}

typedef pg8::bf16x8 bf16x8;
typedef short s16x4 __attribute__((ext_vector_type(4)));
DI bf16x8 ldg8(const bf16_t* p) { return *(const bf16x8*)p; }
DI bf16x8 lds8(const LAS unsigned char* p) { return *(const LAS bf16x8*)p; }
#define MFMA16(a, b, c) __builtin_amdgcn_mfma_f32_16x16x32_bf16((a), (b), (c), 0, 0, 0)
DI bf16x8 lds_tr8(const LAS unsigned char* img, int pitch, int lane) {
#if defined(__HIP_DEVICE_COMPILE__)
    const int g = lane >> 4, q = (lane & 15) >> 2, pp = lane & 3;
    const LAS unsigned char* a = img + (8 * g + q) * pitch + 8 * pp;
    const s16x4 lo = __builtin_amdgcn_ds_read_tr16_b64_v4i16((LAS s16x4*)a), hi = __builtin_amdgcn_ds_read_tr16_b64_v4i16((LAS s16x4*)(a + 4 * pitch));
    return __builtin_shufflevector(lo, hi, 0, 1, 2, 3, 4, 5, 6, 7);
#else
    return bf16x8{};
#endif
}
DI u32x4 lds_ld16(const LAS unsigned char* p) {
#if defined(__HIP_DEVICE_COMPILE__)
    return *(const LAS u32x4*)p;
#else
    return u32x4{};
#endif
}
DI void lds_st16(LAS unsigned char* p, u32x4 v) {
#if defined(__HIP_DEVICE_COMPILE__)
    *(LAS u32x4*)p = v;
#endif
}
DI void lds_st8(LAS unsigned char* p, u32x2 v) {
#if defined(__HIP_DEVICE_COMPILE__)
    *(LAS u32x2*)p = v;
#endif
}

DI float lsig2(float x) { const float y = x * 1.44269504f; return (fminf(y, 0.f) - __builtin_amdgcn_logf(1.f + __builtin_amdgcn_exp2f(-fabsf(y)))) * 0.0625f; }
template <int L> DI void ph_g1_fast(const Params& p, const Ws& w, int bid, int nblk, unsigned char* ldsb) {
    constexpr int RS = 544, QT_OFF = 0, KT_OFF = 2 * 64 * RS, A_OFF = 4 * 64 * RS, ARS = 144, VRS = 144;
    LAS unsigned char* lds = (LAS unsigned char*)ldsb;
    float* pg_s = (float*)(ldsb + A_OFF);
    const int tid = threadIdx.x, d = tid >> 8, k = tid & 255, lane = tid & 63, wv = tid >> 6, fr = lane & 15, fq = lane >> 4;
    for (int u = bid; u < NCH * NH; u += nblk) {
        const int cg = u >> 2, h = u & 3, r0 = cg * 64;
        __syncthreads();
        for (int i = tid; i < 64 * 32; i += 512) pg_s[i] = w.pg_()[(size_t)r0 * 32 + i];
        const int kw = (wv & 3) * 64;
        const float* w2 = (d == 0 ? p.gate_w2_f : p.gate_w2_b) + (size_t)L * 16 * 1024 + h * 256 + kw;
        const float* bv = (d == 0 ? p.gate_b_f : p.gate_b_b) + L * 1024 + h * 256 + kw;
        s16x4 bw[4]; float bias4[4];
#pragma unroll
        for (int kb = 0; kb < 4; ++kb) { const float* c0 = w2 + (4 * fq) * 1024 + 16 * kb + fr;
            const unsigned lo = pg8::cvt_pk_bf16(c0[0], c0[1024]), hi = pg8::cvt_pk_bf16(c0[2048], c0[3072]);
            bw[kb] = __builtin_bit_cast(s16x4, (u32x2){lo, hi}); bias4[kb] = bv[16 * kb + fr]; }
        __syncthreads();
        float totk[4] = {0.f, 0.f, 0.f, 0.f};
#pragma unroll
        for (int m = 0; m < 4; ++m) {
            const f32x4 pa = *(const LAS f32x4*)(lds + A_OFF + ((16 * m + fr) * 32 + 16 * d + 4 * fq) * 4);
            const s16x4 af = __builtin_bit_cast(s16x4, (u32x2){pg8::cvt_pk_bf16(pa[0], pa[1]), pg8::cvt_pk_bf16(pa[2], pa[3])});
#pragma unroll
            for (int kb = 0; kb < 4; ++kb) {
                const f32x4 x = __builtin_amdgcn_mfma_f32_16x16x16bf16_1k(af, bw[kb], (f32x4){bias4[kb], bias4[kb], bias4[kb], bias4[kb]}, 0, 0, 0);
                const int l = 16 * kb + fr, la_o = (l < 32 ? QT_OFF : KT_OFF) + d * 64 * RS + 128 * (wv & 3) + 4 * (l & 31);
#pragma unroll
                for (int i = 0; i < 4; ++i) { const float la = lsig2(x[i]); totk[kb] += la; *(LAS float*)(lds + la_o + (16 * m + 4 * fq + i) * RS) = la; }
            }
        }
#pragma unroll
        for (int kb = 0; kb < 4; ++kb) { totk[kb] += __shfl_xor(totk[kb], 16); totk[kb] += __shfl_xor(totk[kb], 32); }
        const float tot = fq == 0 ? totk[0] : fq == 1 ? totk[1] : fq == 2 ? totk[2] : totk[3];
        const int la_off = ((k & 63) < 32 ? QT_OFF : KT_OFF) + d * 64 * RS + 128 * ((k >> 6) & 3) + 4 * (k & 31);
        float cum = 0.f;
        const bf16_t* qbase = w.P_() + (size_t)r0 * LDP + PQ + h * 256 + k; const bf16_t* kbase = w.P_() + (size_t)r0 * LDP + PK + h * 256 + k;
        auto load_blk = [&](int c, bf16_t (&qv_)[8], bf16_t (&kv_)[8]) {
#pragma unroll
            for (int i = 0; i < 8; ++i) { const int t = d ? 63 - (c * 8 + i) : c * 8 + i; qv_[i] = qbase[(size_t)t * LDP]; kv_[i] = kbase[(size_t)t * LDP]; } };
        auto do_blk = [&](int c, const bf16_t (&qv_)[8], const bf16_t (&kv_)[8]) {
            bf16_t kev[8];
#pragma unroll
            for (int i = 0; i < 8; ++i) {
                const int t = d ? 63 - (c * 8 + i) : c * 8 + i;
                cum += *(const LAS float*)(lds + la_off + t * RS);
                const float q = bf2f(qv_[i]), kk = bf2f(kv_[i]);
                const unsigned qk = pg8::cvt_pk_bf16(q * __builtin_amdgcn_exp2f(cum), kk * __builtin_amdgcn_exp2f(-cum));
                const bf16_t qtv = (bf16_t)(qk & 0xffffu), ktv = (bf16_t)(qk >> 16);
                kev[i] = (bf16_t)(pg8::cvt_pk_bf16(kk * __builtin_amdgcn_exp2f(tot - cum), 0.f) & 0xffffu);
                *(LAS bf16_t*)(lds + QT_OFF + (d * 64 + t) * RS + k * 2) = qtv; *(LAS bf16_t*)(lds + KT_OFF + (d * 64 + t) * RS + k * 2) = ktv;
                asm volatile("" ::: "memory");
            }
            const int t0 = d ? 56 - c * 8 : c * 8;
            uint4 o;
            o.x = d ? ((unsigned)kev[7] | ((unsigned)kev[6] << 16)) : ((unsigned)kev[0] | ((unsigned)kev[1] << 16));
            o.y = d ? ((unsigned)kev[5] | ((unsigned)kev[4] << 16)) : ((unsigned)kev[2] | ((unsigned)kev[3] << 16));
            o.z = d ? ((unsigned)kev[3] | ((unsigned)kev[2] << 16)) : ((unsigned)kev[4] | ((unsigned)kev[5] << 16));
            o.w = d ? ((unsigned)kev[1] | ((unsigned)kev[0] << 16)) : ((unsigned)kev[6] | ((unsigned)kev[7] << 16));
            *(uint4*)(w.ket_() + ((((size_t)d * NCH + cg) * 4 + h) * 256 + k) * 64 + t0) = o;
        };
        { bf16_t qA[8], kA[8], qB[8], kB[8];
          load_blk(0, qA, kA);
#pragma unroll 1
          for (int c = 0; c < 8; c += 2) { load_blk(c + 1, qB, kB); do_blk(c, qA, kA); load_blk(c + 2 < 8 ? c + 2 : 7, qA, kA); do_blk(c + 1, qB, kB); } }
        w.gd_()[((size_t)d * NCH + cg) * 1024 + h * 256 + k] = __builtin_amdgcn_exp2f(tot);
        __syncthreads();
#pragma unroll
        for (int i = 0; i < 8; ++i) { const int idx = tid + i * 512, row = idx >> 5, pc = idx & 31;
            *(u32x4*)(w.qt_() + ((size_t)(row >> 6) * MT + r0 + (row & 63)) * 1024 + h * 256 + pc * 8) = lds_ld16(lds + QT_OFF + row * RS + pc * 16); }
        if (L == 1 && cg >= 128) continue;
        { const int mi = wv & 3;
#pragma unroll
          for (int sb = 0; sb < 2; ++sb) { const int si = 2 * (wv >> 2) + sb;
              f32x4 af = {0.f, 0.f, 0.f, 0.f}, ab = {0.f, 0.f, 0.f, 0.f};
              if (si <= mi) {
#pragma unroll
                  for (int ks = 0; ks < 8; ++ks) af = MFMA16(lds8(lds + KT_OFF + (16 * si + fr) * RS + (32 * ks + 8 * fq) * 2), lds8(lds + QT_OFF + (16 * mi + fr) * RS + (32 * ks + 8 * fq) * 2), af); }
              if (si >= mi) {
#pragma unroll
                  for (int ks = 0; ks < 8; ++ks) ab = MFMA16(lds8(lds + KT_OFF + (64 + 16 * si + fr) * RS + (32 * ks + 8 * fq) * 2), lds8(lds + QT_OFF + (64 + 16 * mi + fr) * RS + (32 * ks + 8 * fq) * 2), ab); }
              float v[4];
#pragma unroll
              for (int r = 0; r < 4; ++r) { const int sl = 16 * si + 4 * fq + r, tl = 16 * mi + fr; v[r] = (sl <= tl ? af[r] : 0.f) + (sl >= tl ? ab[r] : 0.f); }
              asm volatile("s_nop 0" ::: "memory");
              u32x2 pk; pk.x = pg8::cvt_pk_bf16(v[0], v[1]); pk.y = pg8::cvt_pk_bf16(v[2], v[3]);
              lds_st8(lds + A_OFF + (16 * mi + fr) * ARS + (16 * si + 4 * fq) * 2, pk); } }
        __syncthreads();
        constexpr int VP = 1056;
#pragma unroll
        for (int i = 0; i < 8; ++i) { const int idx = tid + i * 512, sr = idx >> 6, pc = idx & 63;
            lds_st16(lds + sr * VP + pc * 16, *(const u32x4*)(w.P_() + (size_t)(r0 + sr) * LDP + PV + h * 512 + pc * 8)); }
        __syncthreads();
        { f32x4 acc[4][4];
#pragma unroll
          for (int nb = 0; nb < 4; ++nb)
#pragma unroll
              for (int mb = 0; mb < 4; ++mb) acc[nb][mb] = (f32x4){0.f, 0.f, 0.f, 0.f};
#pragma unroll
          for (int ks = 0; ks < 2; ++ks) { bf16x8 af[4], vf[4];
#pragma unroll
              for (int mb = 0; mb < 4; ++mb) af[mb] = lds8(lds + A_OFF + (16 * mb + fr) * ARS + (32 * ks + 8 * fq) * 2);
#pragma unroll
              for (int nb = 0; nb < 4; ++nb) vf[nb] = lds_tr8(lds + (32 * ks) * VP + (64 * wv + 16 * nb) * 2, VP, lane);
#pragma unroll
              for (int nb = 0; nb < 4; ++nb)
#pragma unroll
                  for (int mb = 0; mb < 4; ++mb) acc[nb][mb] = MFMA16(vf[nb], af[mb], acc[nb][mb]); }
#pragma unroll
          for (int nb = 0; nb < 4; ++nb)
#pragma unroll
              for (int mb = 0; mb < 4; ++mb) { u32x2 pk; pk.x = pg8::cvt_pk_bf16(acc[nb][mb][0], acc[nb][mb][1]); pk.y = pg8::cvt_pk_bf16(acc[nb][mb][2], acc[nb][mb][3]);
                  *(u32x2*)(w.oi_() + (size_t)(r0 + 16 * mb + fr) * D + h * 512 + 64 * wv + 16 * nb + 4 * fq) = pk; } }
    }
    { unsigned char* lds = ldsb; CONV_SLOT(L == 0 ? 0 : 8, NCH * NH); }
}

DI int st_addr(int n, int kbyte) { return n * 528 + kbyte; }
template <int L> DI void ph_g2_fast(const Params& p, const Ws& w, int bid, int nblk, unsigned char* ldsb) {
    constexpr int VRS = 288, VTB = 64 * VRS, V_OFF = 128 * 528, G_OFF = V_OFF + 2 * VTB;
    LAS unsigned char* lds = (LAS unsigned char*)ldsb;
    const int tid = threadIdx.x, lane = tid & 63, wv = tid >> 6, fr = lane & 15, fq = lane >> 4, mq = wv & 3, nh = wv >> 2;
    const int ng2 = nblk >= 256 ? 128 : nblk;
    if (bid >= ng2) { conv_slot_direct(p, slot_begin(L == 0 ? 1 : 9), slot_begin(L == 0 ? 2 : 10), bid - ng2, nblk - ng2, ldsb); return; }
    for (int u = bid; u < 128; u += ng2) {
        const int xcd = u & 7, idx = u >> 3, chain = xcd * 4 + (idx >> 2), j = idx & 3, d = chain & 1, h = (chain >> 1) & 3, b = chain >> 3;
        auto chunk_of = [&](int step) { return step < 4 ? 128 + b * 4 + (d ? 3 - step : step) : b * 32 + (d ? 31 - (step - 4) : (step - 4)); };
        auto vsrc = [&](int step) { return (const u32x4*)(w.P_() + (size_t)(chunk_of(step) * 64 + (tid >> 3)) * LDP + PV + h * 512 + j * 128 + (tid & 7) * 16); };
        auto vpark = [&](int stage, const u32x4 a0, const u32x4 a1) { LAS unsigned char* q = lds + V_OFF + stage * VTB + (tid >> 3) * VRS + (tid & 7) * 32; lds_st16(q, a0); lds_st16(q + 16, a1); };
        auto gsrc = [&](int step) { return (const u32x4*)(w.gd_() + ((size_t)d * NCH + chunk_of(step)) * 1024 + h * 256 + (tid & 63) * 4); };
        auto gpark = [&](int stage, const u32x4 g4) { if (tid < 64) lds_st16(lds + G_OFF + stage * 1024 + tid * 16, g4); };
        __syncthreads();
        for (int i = tid; i < 128 * 528 / 16; i += 512) lds_st16(lds + i * 16, (u32x4){0u, 0u, 0u, 0u});
        { const u32x4* s0 = vsrc(0); vpark(0, s0[0], s0[1]); gpark(0, *gsrc(0)); }
        __syncthreads();
        f32x4 S[2][8];
#pragma unroll
        for (int kb = 0; kb < 2; ++kb)
#pragma unroll
            for (int nb = 0; nb < 8; ++nb) S[kb][nb] = (f32x4){0.f, 0.f, 0.f, 0.f};
        bf16x8 ke[2][2], qa[8];
        auto load_upd = [&](int step, bf16x8 (&ke_)[2][2]) {
            const int cg = chunk_of(step);
            const bf16_t* kep = w.ket_() + ((((size_t)d * NCH + cg) * 4 + h) * 256 + 32 * wv) * 64;
#pragma unroll
            for (int kb = 0; kb < 2; ++kb)
#pragma unroll
                for (int s2 = 0; s2 < 2; ++s2) ke_[kb][s2] = ldg8(kep + (16 * kb + fr) * 64 + 32 * s2 + 8 * fq);
        };
        auto load_q = [&](int step) {
            const bf16_t* qtp = w.qt_() + ((size_t)d * MT + chunk_of(step) * 64 + 16 * mq + fr) * 1024 + h * 256;
#pragma unroll
            for (int s8 = 0; s8 < 8; ++s8) qa[s8] = ldg8(qtp + 32 * s8 + 8 * fq);
        };
        auto compute_step = [&](int step, const bf16x8 (&ke_)[2][2], const u32x4 vn0, const u32x4 vn1, const u32x4 gn) {
            const int cg = chunk_of(step), cur = step & 1;
            f32x4 gv_[2];
#pragma unroll
            for (int kb = 0; kb < 2; ++kb) gv_[kb] = *(const LAS f32x4*)(lds + G_OFF + cur * 1024 + (32 * wv + 16 * kb + 4 * fq) * 4);
#pragma unroll
            for (int kb = 0; kb < 2; ++kb)
#pragma unroll
                for (int nb = 0; nb < 8; ++nb) S[kb][nb] = S[kb][nb] * gv_[kb];
#pragma unroll
            for (int s2 = 0; s2 < 2; ++s2)
#pragma unroll
                for (int nb = 0; nb < 8; ++nb) { const bf16x8 vf = lds_tr8(lds + V_OFF + cur * VTB + (32 * s2) * VRS + (16 * nb) * 2, VRS, lane);
#pragma unroll
                    for (int kb = 0; kb < 2; ++kb) S[kb][nb] = MFMA16(ke_[kb][s2], vf, S[kb][nb]);
                    if (nb & 1) asm volatile("" ::: "memory"); }
            if (L == 0 || cg < 128)
#pragma unroll
            for (int hb = 0; hb < 2; ++hb) {
                f32x4 O[2] = {(f32x4){0.f, 0.f, 0.f, 0.f}, (f32x4){0.f, 0.f, 0.f, 0.f}};
#pragma unroll
                for (int s8 = 0; s8 < 8; ++s8)
#pragma unroll
                    for (int n2 = 0; n2 < 2; ++n2) O[n2] = MFMA16(lds8(lds + st_addr(64 * nh + 32 * hb + 16 * n2 + fr, (32 * s8 + 8 * fq) * 2)), qa[s8], O[n2]);
#pragma unroll
                for (int n2 = 0; n2 < 2; ++n2) { u32x2 pk; pk.x = pg8::cvt_pk_bf16(O[n2][0], O[n2][1]); pk.y = pg8::cvt_pk_bf16(O[n2][2], O[n2][3]);
                    *(u32x2*)(w.of_() + ((size_t)d * MT + cg * 64 + 16 * mq + fr) * D + h * 512 + j * 128 + 64 * nh + 32 * hb + 16 * n2 + 4 * fq) = pk; }
            }
            load_q(step + 1 < 36 ? step + 1 : 35);
            asm volatile("s_waitcnt lgkmcnt(0)" ::: "memory"); __builtin_amdgcn_s_barrier(); asm volatile("" ::: "memory");
#pragma unroll
            for (int kb = 0; kb < 2; ++kb)
#pragma unroll
                for (int nb = 0; nb < 8; ++nb) { u32x2 pk; pk.x = pg8::cvt_pk_bf16(S[kb][nb][0], S[kb][nb][1]); pk.y = pg8::cvt_pk_bf16(S[kb][nb][2], S[kb][nb][3]);
                    lds_st8(lds + st_addr(16 * nb + fr, (32 * wv + 16 * kb + 4 * fq) * 2), pk); }
            vpark(cur ^ 1, vn0, vn1); gpark(cur ^ 1, gn);
            asm volatile("s_waitcnt lgkmcnt(0)" ::: "memory"); __builtin_amdgcn_s_barrier(); asm volatile("" ::: "memory");
        };
        load_upd(0, ke); load_q(0);
#pragma unroll 1
        for (int step = 0; step < 36; step += 2) {
            bf16x8 keN[2][2];
            { const u32x4* sb = vsrc(step + 1); const u32x4 vb0 = sb[0], vb1 = sb[1], gb = *gsrc(step + 1);
              load_upd(step + 1, keN);
              compute_step(step, ke, vb0, vb1, gb); }
            { const int sn = step + 2 < 36 ? step + 2 : 35; const u32x4* sa = vsrc(sn); const u32x4 va0 = sa[0], va1 = sa[1], ga = *gsrc(sn);
              load_upd(sn, ke);
              compute_step(step + 1, keN, va0, va1, ga); }
        }
    }
}

constexpr int LDS_BYTES = 155648;
constexpr int PH_ADA = 0, PH_MODFIN = 1, PH_T1 = 2, PH_L0 = 3, NPL = 13, NPH = PH_L0 + 2 * NPL;
constexpr int L_INPROJ = 0, L_G1 = 1, L_G2 = 2, L_G3 = 3, L_PA = 4, L_PB = 5, L_MC = 6, L_WO = 7, L_T2 = 8, L_SCAT = 9, L_F1 = 10, L_F2 = 11, L_T3 = 12;

#ifndef PHSEL
#define PHSEL(k) true
#endif
#ifndef REPEAT
#define REPEAT 0
#endif
constexpr int RB_CONV = 1, RB_INPROJ = 2, RB_G1 = 4, RB_G2 = 8, RB_G3 = 16, RB_PAB = 32, RB_WO = 64, RB_F1 = 128, RB_F2 = 256, RB_ADA = 512, RB_T1 = 1024, RB_SCAT = 2048;
#define REP(bit) for (int rep_ = 0; rep_ < ((REPEAT & (bit)) ? 2 : 1); ++rep_)
#define REP2(bit, call) do { if (REPEAT & (bit)) { call; } call; } while (0)
template <int L> DI void layer_phases(const Params& p, const Ws& w, int bid, int nblk, unsigned char* lds, const XcdBarrier& bar) {
    const int lo = p.ph_lo, hi = p.ph_hi, base = PH_L0 + L * NPL;
#define IN(k) (PHSEL(base + (k)) && lo <= base + (k) && base + (k) < hi)
#define SEAM(k) do { if (lo <= base + (k) && base + (k) + 1 < hi) xcd_barrier(bar); } while (0)
    if (IN(L_INPROJ)) { if (FAST & FB_INPROJ) REP2(RB_INPROJ, ph_inproj_fast<L>(p, w, bid, nblk, lds)); else ph_inproj_naive<L>(p, w, bid, nblk, lds); }
    SEAM(L_INPROJ);
    if (IN(L_G1)) REP(RB_G1) { if (FAST & FB_G1) ph_g1_fast<L>(p, w, bid, nblk, lds); else ph_g1_naive<L>(p, w, bid, nblk, lds); }
    SEAM(L_G1);
    if (IN(L_G2)) REP(RB_G2) { if (FAST & FB_G2) ph_g2_fast<L>(p, w, bid, nblk, lds); else ph_g2_naive<L>(p, w, bid, nblk, lds); }
    if (IN(L_G2) && (!(FAST & FB_G2) || nblk < 256)) conv_slot_direct(p, slot_begin(L == 0 ? 1 : 9), slot_begin(L == 0 ? 2 : 10), bid, nblk, lds);
    SEAM(L_G2);
    if (IN(L_G3)) REP(RB_G3) ph_g3<L>(p, w, bid, nblk);
    SEAM(L_G3);
    if (IN(L_PA)) REP(RB_PAB) { if (FAST & FB_PA) ph_pa_fast<L>(p, w, bid, nblk, lds); else ph_pa_naive<L>(p, w, bid, nblk, lds); }
    if (!((FAST & FB_PA) && (FAST & FB_PB))) SEAM(L_PA);
    if (IN(L_PB)) REP(RB_PAB) { if (FAST & FB_PB) ph_pb_fast<L>(p, w, bid, nblk, lds); else ph_pb_naive<L>(p, w, bid, nblk, lds); }
    SEAM(L_PB);
    if (L == 0) { if (IN(L_MC) && (FAST & FB_PA) && (FAST & FB_PB)) ph_mrg_ctx(w, bid, nblk); SEAM(L_MC); }
    if (IN(L_WO)) REP(RB_WO) { if (FAST & FB_WO) ph_wo_fast<L>(p, w, bid, nblk, lds); else ph_wo_naive<L>(p, w, bid, nblk, lds); }
    SEAM(L_WO);
    if (IN(L_T2)) ph_t2<L>(p, w, bid, nblk, lds);
    SEAM(L_T2);
    if (L == 1) { if (IN(L_SCAT)) REP(RB_SCAT) { if (FAST & FB_CONV) conv_stream([&](int i) { return conv_deferred(p, p.ws, i); }, slot_begin(NSLOT), DT_END, bid, nblk, lds);
        ph_scatter(p, w, bid, nblk); } SEAM(L_SCAT); }
    if (IN(L_F1)) { if (FAST & FB_F1) REP2(RB_F1, ph_f1_fast<L>(p, w, bid, nblk, lds)); else ph_f1_naive<L>(p, w, bid, nblk, lds); }
    SEAM(L_F1);
    if (IN(L_F2)) { if (FAST & FB_F2) REP2(RB_F2, ph_f2_fast<L>(p, w, bid, nblk, lds)); else ph_f2_naive<L>(p, w, bid, nblk, lds); }
    SEAM(L_F2);
    if (IN(L_T3)) ph_t3<L>(p, w, bid, nblk);
    if (L == 0) SEAM(L_T3);
#undef SEAM
#undef IN
}

__global__ void __launch_bounds__(512, 2) k_fwd(Params p) {
    extern __shared__ __attribute__((aligned(16))) unsigned char lds[];
    const Ws w = make_ws(p.ws);
    const int bid = blockIdx.x, nblk = gridDim.x;
    volatile LAS unsigned* bst = (volatile LAS unsigned*)(lds + LDS_BYTES - 16);
    if (threadIdx.x == 0) { bst[0] = 0u; bst[1] = 0u; bst[2] = 0u; bst[3] = 0u; }
    __syncthreads();
    XcdBarrier bar; bar.bar = w.ctl_() + CW_BAR; bar.x = 0; bar.st = bst;
    if (p.ph_hi - p.ph_lo > 1) bar = xcd_barrier_post(w.ctl_() + CW_BAR, bst);
    const int lo = p.ph_lo, hi = p.ph_hi;
#define SEAM0(k) do { if (lo <= (k) && (k) + 1 < hi) xcd_barrier(bar); } while (0)
    if (PHSEL(PH_ADA) && lo <= PH_ADA && PH_ADA < hi) { REP(RB_ADA) ph_ada(p, w, bid, nblk, lds); if (FAST & FB_CONV) REP(RB_CONV) ph_convert(p, p.ws, bid, nblk, lds); }
    SEAM0(PH_ADA);
    if (PHSEL(PH_MODFIN) && lo <= PH_MODFIN && PH_MODFIN < hi) ph_modfin(p, w, bid, nblk);
    SEAM0(PH_MODFIN);
    if (PHSEL(PH_T1) && lo <= PH_T1 && PH_T1 < hi) REP(RB_T1) ph_t1(p, w, bid, nblk);
    SEAM0(PH_T1);
#undef SEAM0
    layer_phases<0>(p, w, bid, nblk, lds, bar);
    layer_phases<1>(p, w, bid, nblk, lds, bar);
}

extern "C" void kernel_launch(void* const* d_in, const int* in_sizes, int n_in, void* d_out, int out_size, void* d_ws, size_t ws_size, hipStream_t stream) {
    static int grid = 0;
    if (grid == 0) {
        if (n_in != 28 || ws_size < WS_END2) { fprintf(stderr, "kernel_launch: expected 28 inputs and >= %zu bytes of workspace; got %d, %zu\n", (size_t)WS_END2, n_in, ws_size); grid = -1; return; }
        int dev = 0, cus = 0;
        if (hipGetDevice(&dev) != hipSuccess || hipDeviceGetAttribute(&cus, hipDeviceAttributeMultiprocessorCount, dev) != hipSuccess) { grid = -1; return; }
        if (hipFuncSetAttribute((const void*)k_fwd, hipFuncAttributeMaxDynamicSharedMemorySize, LDS_BYTES) != hipSuccess) { fprintf(stderr, "kernel_launch: hipFuncSetAttribute failed\n"); grid = -1; return; }
        grid = cus > 0 ? cus : 256;
    }
    if (grid < 0) return;
    (void)hipMemsetAsync((char*)d_ws + WS_CTL, 0, CTL_BYTES, stream);
    Params p{};
    const float** pp = (const float**)&p;
    for (int i = 0; i < 28; ++i) pp[i] = (const float*)d_in[i];
    p.out = (float*)d_out; p.ws = (unsigned char*)d_ws;
#ifndef MK_PER_PHASE
    p.ph_lo = 0; p.ph_hi = NPH;
    hipLaunchKernelGGL(k_fwd, dim3(grid), dim3(512), LDS_BYTES, stream, p);
#else
    for (int ph = 0; ph < NPH; ++ph) {
        if (ph == PH_L0 + L_SCAT || ph == PH_L0 + NPL + L_MC) continue;
        p.ph_lo = ph; p.ph_hi = ph + 1;
        hipLaunchKernelGGL(k_fwd, dim3(grid), dim3(512), LDS_BYTES, stream, p);
    }
#endif
}
```

```cpp
#include <hip/hip_runtime.h>
#include <cstdio>
#include <cstdint>

#define DI __device__ __forceinline__
typedef unsigned short bf16_t;
typedef float f32x4 __attribute__((ext_vector_type(4)));

constexpr int D = 2048, NBATCH = 4, SEQ = 2048, CTXL = 256;
constexpr int ML = NBATCH * SEQ, MC = NBATCH * CTXL, MT = ML + MC;
constexpr int HK = 256, HV = 512, NH = 4, DFF = 5632, NE = 8;
constexpr int NIN = 16416;
constexpr int OFF_Q = 0, OFF_K = 1024, OFF_V = 2048, OFF_AF = 4096, OFF_R = 4128, OFF_CB = 6176, OFF_CC = 8224, OFF_CX = 10272, OFF_GA = 12320, OFF_GB = 14368;
constexpr int PQ = 0, PK = 1024, PV = 2048, PSR = 4096, PCB = 6144, PU = 8192, PGA = 10240, PGB = 12288, LDP = 14336 + 1024;
constexpr int NCH = MT / 64;
constexpr int MSORT = 18432;
constexpr float EPS = 1e-6f;

constexpr size_t al256(size_t x) { return (x + 255) & ~(size_t)255; }
constexpr size_t WS_CTL = 0, CTL_BYTES = 1u << 20;
constexpr size_t WS_MODP = WS_CTL + CTL_BYTES;
constexpr size_t WS_MOD = WS_MODP + al256((size_t)8 * 2 * 5 * 12288 * 4);
constexpr size_t WS_XS = WS_MOD + al256((size_t)2 * 5 * 12288 * 4);
constexpr size_t WS_H = WS_XS + (size_t)MT * D * 4;
constexpr size_t WS_PG = WS_H + (size_t)MT * D * 2;
constexpr size_t WS_P = WS_PG + (size_t)MT * 32 * 4;
constexpr size_t WS_GG = WS_P;
constexpr size_t P_BYTES = (size_t)MT * LDP * 2;
static_assert((size_t)MSORT * DFF * 2 <= P_BYTES, "GG overlay");
constexpr size_t WS_GLA = WS_P + P_BYTES;
constexpr size_t WS_QT = WS_GLA;
constexpr size_t WS_KET = WS_QT + (size_t)2 * MT * 1024 * 2;
constexpr size_t WS_VT = WS_KET + (size_t)2 * NCH * 4 * 256 * 64 * 2;
constexpr size_t WS_OI = WS_VT + (size_t)NCH * 4 * 512 * 64 * 2;
constexpr size_t WS_OF = WS_OI + (size_t)MT * D * 2;
constexpr size_t WS_GD = WS_OF + (size_t)2 * MT * D * 2;
constexpr size_t GLA_END = WS_GD + (size_t)2 * NCH * 1024 * 4;
constexpr size_t WS_HS = WS_GLA;
constexpr size_t WS_YS = WS_HS + (size_t)MSORT * D * 2;
constexpr size_t MOE_END = WS_YS + (size_t)MSORT * D * 4;
constexpr size_t WS_OBR = (GLA_END > MOE_END ? GLA_END : MOE_END);
constexpr size_t WS_YA = WS_OBR + (size_t)MT * D * 2;
constexpr size_t WS_MA = WS_YA + (size_t)MT * D * 2;
constexpr size_t WS_MRG = WS_MA + (size_t)MT * D * 4;
constexpr size_t WS_MM = WS_MRG + (size_t)MT * D * 2;
constexpr size_t WS_TOK = WS_MM + (size_t)MT * D * 4;
constexpr size_t WS_END = WS_TOK + (size_t)ML * 2 * 4 * 3;
constexpr int CW_BAR = 0;
constexpr int CW_CNT = 8192;
#ifndef FAST
#define FAST 0xFFFF
#endif
constexpr int FB_CONV = 1, FB_INPROJ = 2, FB_PA = 4, FB_PB = 8, FB_WO = 16, FB_F1 = 32, FB_F2 = 64, FB_G1 = 128, FB_G2 = 256;
constexpr size_t WS_WIN = WS_END;
constexpr size_t WS_WG = WS_WIN + (size_t)2 * 16384 * 2048 * 2;
constexpr size_t WS_WA = WS_WG + (size_t)2 * 64 * 2048 * 2;
constexpr size_t WS_WB = WS_WA + (size_t)2 * 2048 * 2048 * 2;
constexpr size_t WS_WO = WS_WB + (size_t)2 * 2048 * 2048 * 2;
constexpr size_t WS_F1 = WS_WO + (size_t)2 * 2048 * 2048 * 2;
constexpr size_t WS_F2 = WS_F1 + (size_t)11264 * 2048 * 2;
constexpr size_t WS_M1 = WS_F2 + (size_t)2048 * 5632 * 2;
constexpr size_t WS_M2 = WS_M1 + (size_t)8 * 11264 * 2048 * 2;
constexpr size_t WS_MMP = WS_M2 + (size_t)8 * 2048 * 5632 * 2;
constexpr size_t WS_YSP = WS_MMP + (size_t)4 * MC * D * 4;
constexpr size_t WS_END2 = WS_YSP + (size_t)4 * 2048 * D * 4;

struct Params {
    const float *x, *c, *ctx, *c_ctx, *w_ada, *b_ada, *pre_mix_g, *post_mix_g, *pre_ffn_g, *post_ffn_g, *w_in, *gate_w2_f, *gate_b_f, *gate_w2_b, *gate_b_b,
        *gla_norm_g, *conv_w, *conv_b, *w_proj_a, *w_proj_b, *w_out, *ffn_w1, *ffn_w3, *ffn_w2, *router_w, *moe_w1, *moe_w3, *moe_w2;
    float* out; unsigned char* ws; int ph_lo, ph_hi;
};

DI float bf2f(bf16_t v) { return __uint_as_float((unsigned)v << 16); }
DI bf16_t f2bf(float f) { unsigned u = __float_as_uint(f); u += 0x7FFFu + ((u >> 16) & 1u); return (bf16_t)(u >> 16); }
DI unsigned pack2(float lo, float hi) { return (unsigned)f2bf(lo) | ((unsigned)f2bf(hi) << 16); }
DI float siluf(float v) { return v / (1.f + __expf(-v)); }
DI float sigmf(float v) { return 1.f / (1.f + __expf(-v)); }
DI float wave_sum(float s) {
#pragma unroll
    for (int o = 32; o >= 1; o >>= 1) s += __shfl_xor(s, o);
    return s;
}
DI void ld_row_f32(const float* p, int lane, float (&v)[4][8]) {
#pragma unroll
    for (int j = 0; j < 4; ++j) { const float4* q = (const float4*)(p + (j * 64 + lane) * 8); const float4 a = q[0], b = q[1];
        v[j][0] = a.x; v[j][1] = a.y; v[j][2] = a.z; v[j][3] = a.w; v[j][4] = b.x; v[j][5] = b.y; v[j][6] = b.z; v[j][7] = b.w; }
}
typedef float f32x4n __attribute__((ext_vector_type(4)));
typedef unsigned u32x4n __attribute__((ext_vector_type(4)));
DI void ld_row_f32_nt(const float* p, int lane, float (&v)[4][8]) {
#pragma unroll
    for (int j = 0; j < 4; ++j) { const f32x4n* q = (const f32x4n*)(p + (j * 64 + lane) * 8); const f32x4n a = __builtin_nontemporal_load(q), b = __builtin_nontemporal_load(q + 1);
        v[j][0] = a[0]; v[j][1] = a[1]; v[j][2] = a[2]; v[j][3] = a[3]; v[j][4] = b[0]; v[j][5] = b[1]; v[j][6] = b[2]; v[j][7] = b[3]; }
}
DI void ld_row_bf16_nt(const bf16_t* p, int lane, float (&v)[4][8]) {
#pragma unroll
    for (int j = 0; j < 4; ++j) { const u32x4n w = __builtin_nontemporal_load((const u32x4n*)(p + (j * 64 + lane) * 8));
        v[j][0] = __uint_as_float(w[0] << 16); v[j][1] = __uint_as_float(w[0] & 0xffff0000u); v[j][2] = __uint_as_float(w[1] << 16); v[j][3] = __uint_as_float(w[1] & 0xffff0000u);
        v[j][4] = __uint_as_float(w[2] << 16); v[j][5] = __uint_as_float(w[2] & 0xffff0000u); v[j][6] = __uint_as_float(w[3] << 16); v[j][7] = __uint_as_float(w[3] & 0xffff0000u); }
}
DI void ld8_bf16_nt(const bf16_t* p, float (&v)[8]) { const u32x4n w = __builtin_nontemporal_load((const u32x4n*)p);
    v[0] = __uint_as_float(w[0] << 16); v[1] = __uint_as_float(w[0] & 0xffff0000u); v[2] = __uint_as_float(w[1] << 16); v[3] = __uint_as_float(w[1] & 0xffff0000u);
    v[4] = __uint_as_float(w[2] << 16); v[5] = __uint_as_float(w[2] & 0xffff0000u); v[6] = __uint_as_float(w[3] << 16); v[7] = __uint_as_float(w[3] & 0xffff0000u); }
DI void ld_row_part4(const float* p, size_t stride, int lane, float (&v)[4][8]) {
    float t[4][8]; ld_row_f32(p, lane, v);
#pragma unroll
    for (int s = 1; s < 4; ++s) { ld_row_f32(p + s * stride, lane, t);
#pragma unroll
        for (int j = 0; j < 4; ++j)
#pragma unroll
            for (int i = 0; i < 8; ++i) v[j][i] += t[j][i]; }
}
DI void ld_row_bf16(const bf16_t* p, int lane, float (&v)[4][8]) {
#pragma unroll
    for (int j = 0; j < 4; ++j) { const uint4 w = *(const uint4*)(p + (j * 64 + lane) * 8);
        v[j][0] = __uint_as_float(w.x << 16); v[j][1] = __uint_as_float(w.x & 0xffff0000u); v[j][2] = __uint_as_float(w.y << 16); v[j][3] = __uint_as_float(w.y & 0xffff0000u);
        v[j][4] = __uint_as_float(w.z << 16); v[j][5] = __uint_as_float(w.z & 0xffff0000u); v[j][6] = __uint_as_float(w.w << 16); v[j][7] = __uint_as_float(w.w & 0xffff0000u); }
}
DI void ld8_f32(const float* p, float (&v)[8]) { const float4* q = (const float4*)p; const float4 a = q[0], b = q[1]; v[0] = a.x; v[1] = a.y; v[2] = a.z; v[3] = a.w; v[4] = b.x; v[5] = b.y; v[6] = b.z; v[7] = b.w; }
DI void ld8_bf16(const bf16_t* p, float (&v)[8]) { const uint4 w = *(const uint4*)p;
    v[0] = __uint_as_float(w.x << 16); v[1] = __uint_as_float(w.x & 0xffff0000u); v[2] = __uint_as_float(w.y << 16); v[3] = __uint_as_float(w.y & 0xffff0000u);
    v[4] = __uint_as_float(w.z << 16); v[5] = __uint_as_float(w.z & 0xffff0000u); v[6] = __uint_as_float(w.w << 16); v[7] = __uint_as_float(w.w & 0xffff0000u); }
DI void st_row_f32(float* p, int lane, const float (&v)[4][8]) {
#pragma unroll
    for (int j = 0; j < 4; ++j) { float4* q = (float4*)(p + (j * 64 + lane) * 8); q[0] = make_float4(v[j][0], v[j][1], v[j][2], v[j][3]); q[1] = make_float4(v[j][4], v[j][5], v[j][6], v[j][7]); }
}
DI void st_row_bf16(bf16_t* p, int lane, const float (&v)[4][8]) {
#pragma unroll
    for (int j = 0; j < 4; ++j) { uint4 w; w.x = pack2(v[j][0], v[j][1]); w.y = pack2(v[j][2], v[j][3]); w.z = pack2(v[j][4], v[j][5]); w.w = pack2(v[j][6], v[j][7]); *(uint4*)(p + (j * 64 + lane) * 8) = w; }
}
DI float sumsq(const float (&v)[4][8]) { float s = 0.f;
#pragma unroll
    for (int j = 0; j < 4; ++j)
#pragma unroll
        for (int i = 0; i < 8; ++i) s += v[j][i] * v[j][i];
    return s; }

struct WsV {
    unsigned char* b;
    DI unsigned* ctl_() const { return (unsigned*)(b + WS_CTL); }
    DI float* modp_() const { return (float*)(b + WS_MODP); }
    DI float* mod_() const { return (float*)(b + WS_MOD); }
    DI bf16_t* xs_() const { return (bf16_t*)(b + WS_XS); }
    DI bf16_t* h_() const { return (bf16_t*)(b + WS_H); }
    DI float* pg_() const { return (float*)(b + WS_PG); }
    DI bf16_t* P_() const { return (bf16_t*)(b + WS_P); }
    DI bf16_t* gg_() const { return (bf16_t*)(b + WS_GG); }
    DI bf16_t* qt_() const { return (bf16_t*)(b + WS_QT); }
    DI bf16_t* ket_() const { return (bf16_t*)(b + WS_KET); }
    DI bf16_t* vt_() const { return (bf16_t*)(b + WS_VT); }
    DI bf16_t* oi_() const { return (bf16_t*)(b + WS_OI); }
    DI bf16_t* of_() const { return (bf16_t*)(b + WS_OF); }
    DI float* gd_() const { return (float*)(b + WS_GD); }
    DI bf16_t* hs_() const { return (bf16_t*)(b + WS_HS); }
    DI bf16_t* ys_() const { return (bf16_t*)(b + WS_YS); }
    DI bf16_t* obr_() const { return (bf16_t*)(b + WS_OBR); }
    DI bf16_t* ya_() const { return (bf16_t*)(b + WS_YA); }
    DI bf16_t* ma_() const { return (bf16_t*)(b + WS_MA); }
    DI bf16_t* mrg_() const { return (bf16_t*)(b + WS_MRG); }
    DI bf16_t* mm_() const { return (bf16_t*)(b + WS_MM); }
    DI int* toke_() const { return (int*)(b + WS_TOK); }
    DI int* tokp_() const { return (int*)(b + WS_TOK) + ML * 2; }
    DI float* tokw_() const { return (float*)(b + WS_TOK) + ML * 4; }
};
typedef WsV Ws;
DI Ws make_ws(unsigned char* w) { Ws s; s.b = w; return s; }
DI const float* mod_ptr(const Ws& w, int l, int row, int which) { const int mr = row < ML ? row / SEQ : 4; return w.mod_() + ((size_t)(l * 5 + mr) * 6 + which) * D; }

DI void ph_ada(const Params& p, const Ws& w, int bid, int nblk, unsigned char* ldsb) {
    float* sl = (float*)ldsb;
    const int tid = threadIdx.x, c4 = (tid & 63) * 4, kg = tid >> 6;
    for (int u = bid; u < 2 * 48 * 8; u += nblk) {
        const int ks = u & 7, cb = (u >> 3) % 48, l = u / (8 * 48);
        __syncthreads();
        for (int i = tid; i < 5 * 256; i += 512) { const int r = i >> 8, k = ks * 256 + (i & 255); const float v = r < 4 ? p.c[r * D + k] : p.c_ctx[k]; sl[i] = siluf(v); }
        __syncthreads();
        float acc[5][4];
#pragma unroll
        for (int r = 0; r < 5; ++r)
#pragma unroll
            for (int j = 0; j < 4; ++j) acc[r][j] = 0.f;
        const float* wp = p.w_ada + ((size_t)l * D + ks * 256 + kg * 32) * 12288 + cb * 256 + c4;
#pragma unroll 8
        for (int k = 0; k < 32; ++k) { const f32x4 wv = __builtin_nontemporal_load((const f32x4*)(wp + (size_t)k * 12288));
#pragma unroll
            for (int r = 0; r < 5; ++r) { const float sv = sl[r * 256 + kg * 32 + k];
#pragma unroll
                for (int j = 0; j < 4; ++j) acc[r][j] += sv * wv[j]; } }
        __syncthreads();
        float* red = sl + 5 * 256;
#pragma unroll
        for (int r = 0; r < 5; ++r) *(f32x4*)(red + (kg * 5 + r) * 256 + c4) = (f32x4){acc[r][0], acc[r][1], acc[r][2], acc[r][3]};
        __syncthreads();
        for (int i = tid; i < 5 * 256; i += 512) { const int r = i >> 8, c = i & 255; float sum = 0.f;
#pragma unroll
            for (int g = 0; g < 8; ++g) sum += red[(g * 5 + r) * 256 + c];
            w.modp_()[((size_t)(ks * 2 + l) * 5 + r) * 12288 + cb * 256 + c] = sum; }
    }
}
DI void ph_modfin(const Params& p, const Ws& w, int bid, int nblk) {
    for (int i = bid * 512 + threadIdx.x; i < 2 * 5 * 12288; i += nblk * 512) {
        const int col = i % 12288, l = i / (5 * 12288); float s = p.b_ada[l * 12288 + col];
#pragma unroll
        for (int ks = 0; ks < 8; ++ks) s += w.modp_()[(size_t)ks * 2 * 5 * 12288 + i];
        w.mod_()[i] = s;
    }
}

DI const float* xin_row(const Params& p, int r) { return r < ML ? p.x + (size_t)r * D : p.ctx + (size_t)(r - ML) * D; }
DI void norm_mod_store(const float (&v)[4][8], const float* g, const float* sh, const float* sc, bf16_t* dst, int lane, float (&hout)[4][8]) {
    const float rs = rsqrtf(wave_sum(sumsq(v)) * (1.f / D) + EPS);
    float gv[4][8], a[4][8], b[4][8]; ld_row_f32(g, lane, gv); ld_row_f32(sh, lane, a); ld_row_f32(sc, lane, b);
#pragma unroll
    for (int j = 0; j < 4; ++j)
#pragma unroll
        for (int i = 0; i < 8; ++i) hout[j][i] = v[j][i] * rs * gv[j][i] * (1.f + b[j][i]) + a[j][i];
    st_row_bf16(dst, lane, hout);
}
DI void ph_t1(const Params& p, const Ws& w, int bid, int nblk) {
    const int lane = threadIdx.x & 63, gw = bid * 8 + (threadIdx.x >> 6), nw = nblk * 8;
    for (int r = gw; r < MT; r += nw) {
        float v[4][8], h[4][8]; ld_row_f32_nt(xin_row(p, r), lane, v);
        norm_mod_store(v, p.pre_mix_g, mod_ptr(w, 0, r, 0), mod_ptr(w, 0, r, 1), w.h_() + (size_t)r * D, lane, h);
    }
}
template <int L> DI void ph_t2(const Params& p, const Ws& w, int bid, int nblk, unsigned char* ldsb) {
    constexpr int MR = L == 0 ? MT : ML;
    const int lane = threadIdx.x & 63, gw = bid * 8 + (threadIdx.x >> 6), nw = nblk * 8;
    float* rw_s = (float*)ldsb;
    if (L == 1) { __syncthreads();
        for (int e = threadIdx.x; e < 2048; e += 512) { const float4 a = ((const float4*)p.router_w)[e * 2], b = ((const float4*)p.router_w)[e * 2 + 1];
            rw_s[e] = a.x; rw_s[2048 + e] = a.y; rw_s[4096 + e] = a.z; rw_s[6144 + e] = a.w; rw_s[8192 + e] = b.x; rw_s[10240 + e] = b.y; rw_s[12288 + e] = b.z; rw_s[14336 + e] = b.w; }
        __syncthreads(); }
    for (int r = gw; r < MR; r += nw) {
        float xr[4][8], m[4][8], gv[4][8], g1[4][8], h[4][8];
        if (L == 0) ld_row_f32_nt(xin_row(p, r), lane, xr); else ld_row_bf16_nt(w.xs_() + (size_t)r * D, lane, xr);
        if (L == 0 && (FAST & FB_WO) && r >= ML) ld_row_part4((const float*)(w.b + WS_MMP) + (size_t)(r - ML) * D, (size_t)MC * D, lane, m);
        else ld_row_bf16_nt(w.mm_() + (size_t)r * D, lane, m);
        const float rs = rsqrtf(wave_sum(sumsq(m)) * (1.f / D) + EPS);
        ld_row_f32(p.post_mix_g + L * D, lane, gv); ld_row_f32(mod_ptr(w, L, r, 2), lane, g1);
#pragma unroll
        for (int j = 0; j < 4; ++j)
#pragma unroll
            for (int i = 0; i < 8; ++i) xr[j][i] += g1[j][i] * (m[j][i] * rs * gv[j][i]);
        st_row_bf16(w.xs_() + (size_t)r * D, lane, xr);
        norm_mod_store(xr, p.pre_ffn_g + L * D, mod_ptr(w, L, r, 3), mod_ptr(w, L, r, 4), w.h_() + (size_t)r * D, lane, h);
        if (L == 1) {
            float lg[8] = {0.f, 0.f, 0.f, 0.f, 0.f, 0.f, 0.f, 0.f};
#pragma unroll
            for (int j = 0; j < 4; ++j) {
#pragma unroll
                for (int ex = 0; ex < 8; ++ex) { const float4* rw = (const float4*)(rw_s + ex * 2048 + (j * 64 + lane) * 8); const float4 a = rw[0], b = rw[1];
                    lg[ex] += h[j][0] * a.x + h[j][1] * a.y + h[j][2] * a.z + h[j][3] * a.w + h[j][4] * b.x + h[j][5] * b.y + h[j][6] * b.z + h[j][7] * b.w;
                    if (ex & 1) asm volatile("" ::: "memory"); } }
#pragma unroll
            for (int e = 0; e < 8; ++e) lg[e] = wave_sum(lg[e]);
            if (lane == 0) {
                int e0 = 0; float v0 = lg[0];
#pragma unroll
                for (int e = 1; e < 8; ++e) if (lg[e] > v0) { v0 = lg[e]; e0 = e; }
                int e1 = -1; float v1 = -3.0e38f;
#pragma unroll
                for (int e = 0; e < 8; ++e) if (e != e0 && lg[e] > v1) { v1 = lg[e]; e1 = e; }
                const float p1 = 1.f / (1.f + __expf(v0 - v1)), p0 = 1.f - p1;
                const int q0 = (int)atomicAdd(w.ctl_() + CW_CNT + e0, 1u), q1 = (int)atomicAdd(w.ctl_() + CW_CNT + e1, 1u);
                w.toke_()[r * 2] = e0; w.toke_()[r * 2 + 1] = e1; w.tokp_()[r * 2] = q0; w.tokp_()[r * 2 + 1] = q1; w.tokw_()[r * 2] = p0; w.tokw_()[r * 2 + 1] = p1;
            }
        }
    }
}
DI void moe_offsets(const Ws& w, int (&off)[9]) { int o = 0;
#pragma unroll
    for (int e = 0; e < 8; ++e) { off[e] = o; const int c = (int)__hip_atomic_load(w.ctl_() + CW_CNT + e, __ATOMIC_RELAXED, __HIP_MEMORY_SCOPE_AGENT); o += (c + 255) & ~255; }
    off[8] = o; }
DI void ph_scatter(const Params& p, const Ws& w, int bid, int nblk) {
    int off[9]; moe_offsets(w, off);
    const int lane = threadIdx.x & 63, gw = bid * 8 + (threadIdx.x >> 6), nw = nblk * 8;
    for (int r = gw; r < ML; r += nw) {
        const uint4* __restrict__ src = (const uint4*)(w.h_() + (size_t)r * D);
        const uint4 v0 = src[lane], v1 = src[64 + lane], v2 = src[128 + lane], v3 = src[192 + lane];
        const int e0 = w.toke_()[r * 2], e1 = w.toke_()[r * 2 + 1], q0 = w.tokp_()[r * 2], q1 = w.tokp_()[r * 2 + 1];
        int o0 = 0, o1 = 0;
#pragma unroll
        for (int q = 0; q < 8; ++q) { o0 = (q == e0) ? off[q] : o0; o1 = (q == e1) ? off[q] : o1; }
        uint4* __restrict__ d0 = (uint4*)(w.hs_() + (size_t)(o0 + q0) * D); uint4* __restrict__ d1 = (uint4*)(w.hs_() + (size_t)(o1 + q1) * D);
        d0[lane] = v0; d0[64 + lane] = v1; d0[128 + lane] = v2; d0[192 + lane] = v3;
        d1[lane] = v0; d1[64 + lane] = v1; d1[128 + lane] = v2; d1[192 + lane] = v3;
    }
    for (int e = 0; e < 8; ++e) { const int c = (int)__hip_atomic_load(w.ctl_() + CW_CNT + e, __ATOMIC_RELAXED, __HIP_MEMORY_SCOPE_AGENT); const int lo = off[e] + c, hi = off[e + 1];
        for (int r = lo + gw; r < hi; r += nw) { uint4* dst = (uint4*)(w.hs_() + (size_t)r * D);
#pragma unroll
            for (int j = 0; j < 4; ++j) dst[j * 64 + lane] = make_uint4(0u, 0u, 0u, 0u); } }
}
template <int L> DI void ph_t3(const Params& p, const Ws& w, int bid, int nblk) {
    constexpr int MR = L == 0 ? MT : ML;
    int off[9]; if (L == 1) moe_offsets(w, off);
    const int lane = threadIdx.x & 63, gw = bid * 8 + (threadIdx.x >> 6), nw = nblk * 8;
    for (int r = gw; r < MR; r += nw) {
        float xr[4][8], f[4][8], gv[4][8], g2[4][8];
        ld_row_bf16_nt(w.xs_() + (size_t)r * D, lane, xr);
        if (L == 0) { if ((FAST & FB_F2) && r >= ML) ld_row_part4((const float*)(w.b + WS_MMP) + (size_t)(r - ML) * D, (size_t)MC * D, lane, f); else ld_row_bf16_nt(w.mm_() + (size_t)r * D, lane, f); }
        else {
            float y0[4][8], y1[4][8]; int o0 = 0, o1 = 0; const int e0 = w.toke_()[r * 2], e1 = w.toke_()[r * 2 + 1];
#pragma unroll
            for (int q = 0; q < 8; ++q) { o0 = (q == e0) ? off[q] : o0; o1 = (q == e1) ? off[q] : o1; }
            const int q0 = o0 + w.tokp_()[r * 2], q1 = o1 + w.tokp_()[r * 2 + 1];
            if ((FAST & FB_F2) && q0 >= 16384) ld_row_part4((const float*)(w.b + WS_YSP) + (size_t)(q0 - 16384) * D, (size_t)2048 * D, lane, y0); else ld_row_bf16_nt(w.ys_() + (size_t)q0 * D, lane, y0);
            if ((FAST & FB_F2) && q1 >= 16384) ld_row_part4((const float*)(w.b + WS_YSP) + (size_t)(q1 - 16384) * D, (size_t)2048 * D, lane, y1); else ld_row_bf16_nt(w.ys_() + (size_t)q1 * D, lane, y1);
            const float w0 = w.tokw_()[r * 2], w1 = w.tokw_()[r * 2 + 1];
#pragma unroll
            for (int j = 0; j < 4; ++j)
#pragma unroll
                for (int i = 0; i < 8; ++i) f[j][i] = w0 * y0[j][i] + w1 * y1[j][i];
        }
        const float rs = rsqrtf(wave_sum(sumsq(f)) * (1.f / D) + EPS);
        ld_row_f32(p.post_ffn_g + L * D, lane, gv); ld_row_f32(mod_ptr(w, L, r, 5), lane, g2);
#pragma unroll
        for (int j = 0; j < 4; ++j)
#pragma unroll
            for (int i = 0; i < 8; ++i) xr[j][i] += g2[j][i] * (f[j][i] * rs * gv[j][i]);
        if (L == 0) { st_row_bf16(w.xs_() + (size_t)r * D, lane, xr); float h[4][8];
            norm_mod_store(xr, p.pre_mix_g + D, mod_ptr(w, 1, r, 0), mod_ptr(w, 1, r, 1), w.h_() + (size_t)r * D, lane, h); }
        else st_row_f32(p.out + (size_t)r * D, lane, xr);
    }
}
template <int L> DI void ph_g3(const Params& p, const Ws& w, int bid, int nblk) {
    constexpr int MR = L == 0 ? MT : ML, RB = 4;
    const int lane = threadIdx.x & 63, gw = bid * 8 + (threadIdx.x >> 6), nw = nblk * 8;
#pragma unroll 1
    for (int rb = gw; rb < MR / RB; rb += nw) {
        const int r0 = rb * RB;
        const int pos0 = r0 < ML ? (r0 & 63) : ((r0 - ML) & 255), last = r0 < ML ? 63 : 255;
#pragma unroll
        for (int j = 0; j < 4; ++j) {
            const int e0 = (j * 64 + lane) * 8;
            float ng[8], cw0[8], cw1[8], cw2[8], cbv[8], ul[8], uc[8];
            ld8_f32(p.gla_norm_g + L * D + e0, ng);
            ld8_f32(p.conv_w + (size_t)L * 3 * D + e0, cw0); ld8_f32(p.conv_w + (size_t)L * 3 * D + D + e0, cw1); ld8_f32(p.conv_w + (size_t)L * 3 * D + 2 * D + e0, cw2);
            ld8_f32(p.conv_b + L * D + e0, cbv);
            if (pos0 != 0) ld8_bf16(w.P_() + (size_t)(r0 - 1) * LDP + PU + e0, ul); else {
#pragma unroll
                for (int i = 0; i < 8; ++i) ul[i] = 0.f; }
            ld8_bf16(w.P_() + (size_t)r0 * LDP + PU + e0, uc);
#pragma unroll
            for (int q = 0; q < RB; ++q) {
                const int r = r0 + q;
                float o[8], t[8], ur[8], cbg[8], y[8];
                if (pos0 + q != last) ld8_bf16(w.P_() + (size_t)(r + 1) * LDP + PU + e0, ur); else {
#pragma unroll
                    for (int i = 0; i < 8; ++i) ur[i] = 0.f; }
                ld8_bf16(w.oi_() + (size_t)r * D + e0, o); ld8_bf16(w.of_() + (size_t)r * D + e0, t);
#pragma unroll
                for (int i = 0; i < 8; ++i) o[i] += t[i];
                ld8_bf16(w.of_() + (size_t)(MT + r) * D + e0, t);
                float s = 0.f;
#pragma unroll
                for (int i = 0; i < 8; ++i) { o[i] += t[i]; s += o[i] * o[i]; }
                const float rs = rsqrtf(wave_sum(s) * (1.f / HV) + EPS);
                ld8_bf16(w.P_() + (size_t)r * LDP + PSR + e0, t);
                uint4 ov;
                ov.x = pack2(o[0] * rs * ng[0] * t[0], o[1] * rs * ng[1] * t[1]); ov.y = pack2(o[2] * rs * ng[2] * t[2], o[3] * rs * ng[3] * t[3]);
                ov.z = pack2(o[4] * rs * ng[4] * t[4], o[5] * rs * ng[5] * t[5]); ov.w = pack2(o[6] * rs * ng[6] * t[6], o[7] * rs * ng[7] * t[7]);
                *(uint4*)(w.obr_() + (size_t)r * D + e0) = ov;
                ld8_bf16(w.P_() + (size_t)r * LDP + PCB + e0, cbg);
#pragma unroll
                for (int i = 0; i < 8; ++i) y[i] = cbg[i] * (cbv[i] + cw0[i] * ul[i] + cw1[i] * uc[i] + cw2[i] * ur[i]);
                uint4 yv; yv.x = pack2(y[0], y[1]); yv.y = pack2(y[2], y[3]); yv.z = pack2(y[4], y[5]); yv.w = pack2(y[6], y[7]);
                *(uint4*)(w.ya_() + (size_t)r * D + e0) = yv;
#pragma unroll
                for (int i = 0; i < 8; ++i) { ul[i] = uc[i]; uc[i] = ur[i]; }
            }
            asm volatile("" ::: "memory");
        }
    }
}

struct WSrc { const float* w0; const float* w1; int ld; };
template <int NSRC, class WSel, class Epi>
DI void naive_gemm(const bf16_t* __restrict__ A, int lda, int M, int N, int K, WSel wsel, Epi epi, unsigned char* ldsb, int bid, int nblk) {
    float* As = (float*)ldsb; float* Wl = As + 16 * 68;
    const int tid = threadIdx.x, ty = tid >> 4, tx = tid & 15;
    const int ntm = M / 64, ntn = N / 64;
    for (int tile = bid; tile < ntm * ntn; tile += nblk) {
        const int tm = tile / ntn, tn = tile % ntn, m0 = tm * 64, n0 = tn * 64;
        const WSrc wsrc = wsel(m0, n0);
        float acc[NSRC][2][4];
#pragma unroll
        for (int s = 0; s < NSRC; ++s)
#pragma unroll
            for (int i = 0; i < 2; ++i)
#pragma unroll
                for (int j = 0; j < 4; ++j) acc[s][i][j] = 0.f;
        for (int k0 = 0; k0 < K; k0 += 16) {
            { const unsigned v = *(const unsigned*)(A + (size_t)(m0 + (tid >> 3)) * lda + k0 + (tid & 7) * 2);
              As[((tid & 7) * 2) * 68 + (tid >> 3)] = __uint_as_float(v << 16); As[((tid & 7) * 2 + 1) * 68 + (tid >> 3)] = __uint_as_float(v & 0xffff0000u); }
#pragma unroll
            for (int s = 0; s < NSRC; ++s) { const float2 wv = *(const float2*)((s == 0 ? wsrc.w0 : wsrc.w1) + (size_t)(k0 + (tid >> 5)) * wsrc.ld + (tid & 31) * 2);
                Wl[s * 16 * 68 + (tid >> 5) * 68 + (tid & 31) * 2] = wv.x; Wl[s * 16 * 68 + (tid >> 5) * 68 + (tid & 31) * 2 + 1] = wv.y; }
            __syncthreads();
#pragma unroll
            for (int kk = 0; kk < 16; ++kk) { const float a0 = As[kk * 68 + ty * 2], a1 = As[kk * 68 + ty * 2 + 1];
#pragma unroll
                for (int s = 0; s < NSRC; ++s) { const float4 wv = *(const float4*)(Wl + s * 16 * 68 + kk * 68 + tx * 4);
                    acc[s][0][0] += a0 * wv.x; acc[s][0][1] += a0 * wv.y; acc[s][0][2] += a0 * wv.z; acc[s][0][3] += a0 * wv.w;
                    acc[s][1][0] += a1 * wv.x; acc[s][1][1] += a1 * wv.y; acc[s][1][2] += a1 * wv.z; acc[s][1][3] += a1 * wv.w; } }
            __syncthreads();
        }
#pragma unroll
        for (int i = 0; i < 2; ++i)
#pragma unroll
            for (int j = 0; j < 4; ++j) epi(m0 + ty * 2 + i, n0 + tx * 4 + j, acc[0][i][j], acc[NSRC - 1][i][j]);
    }
}

template <int L> DI void ph_inproj_naive(const Params& p, const Ws& w, int bid, int nblk, unsigned char* lds) {
    const float* win = p.w_in + (size_t)L * D * NIN;
    auto epi = [&](int m, int n, float a0, float a1) {
        bf16_t* P = w.P_() + (size_t)m * LDP;
        if (n < PK) P[n] = f2bf(a0 * 0.0625f);
        else if (n < PSR) P[n] = f2bf(a0);
        else if (n < PCB) P[n] = f2bf(siluf(a0));
        else if (n < PU) P[n] = f2bf(a0);
        else if (n < PGA) P[n] = f2bf(a0 * a1);
        else if (n < LDP) P[n] = f2bf(sigmf(a0));
        else if (n < LDP + 32) w.pg_()[(size_t)m * 32 + (n - LDP)] = a0;
    };
    auto src1 = [&](int n) { return n < PSR ? n   : n < PCB ? OFF_R + (n - PSR) : n < PU ? OFF_CB + (n - PCB) : n < PGB ? OFF_GA + (n - PGA) : n < LDP ? OFF_GB + (n - PGB) : OFF_AF + (n - LDP); };
    naive_gemm<1>(w.h_(), D, MT, PU, D, [&](int, int n0) { return WSrc{win + src1(n0), nullptr, NIN}; }, epi, lds, bid, nblk);
    naive_gemm<1>(w.h_(), D, MT, LDP + 64 - PGA, D, [&](int, int n0) { return WSrc{win + src1(n0 + PGA), nullptr, NIN}; },
                  [&](int m, int n, float a0, float a1) { epi(m, n + PGA, a0, a1); }, lds, bid, nblk);
    naive_gemm<2>(w.h_(), D, MT, 2048, D, [&](int, int n0) { return WSrc{win + OFF_CC + n0, win + OFF_CX + n0, NIN}; },
                  [&](int m, int n, float a0, float a1) { epi(m, n + PU, a0, a1); }, lds, bid, nblk);
}
template <int L> DI void ph_pa_naive(const Params& p, const Ws& w, int bid, int nblk, unsigned char* lds) {
    constexpr int MR = L == 0 ? MT : ML; const float* W0 = p.w_proj_a + (size_t)L * D * D;
    naive_gemm<1>(w.ya_(), D, MR, D, D, [&](int, int n0) { return WSrc{W0 + n0, nullptr, D}; },
                  [&](int m, int n, float a0, float) { w.ma_()[(size_t)m * D + n] = f2bf(a0 * bf2f(w.P_()[(size_t)m * LDP + PGA + n])); }, lds, bid, nblk);
}
template <int L> DI void ph_pb_naive(const Params& p, const Ws& w, int bid, int nblk, unsigned char* lds) {
    constexpr int MR = L == 0 ? MT : ML; const float* W0 = p.w_proj_b + (size_t)L * D * D;
    naive_gemm<1>(w.obr_(), D, MR, D, D, [&](int, int n0) { return WSrc{W0 + n0, nullptr, D}; },
                  [&](int m, int n, float a0, float) { w.mrg_()[(size_t)m * D + n] = f2bf(bf2f(w.ma_()[(size_t)m * D + n]) + a0 * bf2f(w.P_()[(size_t)m * LDP + PGB + n])); }, lds, bid, nblk);
}
template <int L> DI void ph_wo_naive(const Params& p, const Ws& w, int bid, int nblk, unsigned char* lds) {
    constexpr int MR = L == 0 ? MT : ML; const float* W0 = p.w_out + (size_t)L * D * D;
    naive_gemm<1>(w.mrg_(), D, MR, D, D, [&](int, int n0) { return WSrc{W0 + n0, nullptr, D}; },
                  [&](int m, int n, float a0, float) { w.mm_()[(size_t)m * D + n] = f2bf(a0); }, lds, bid, nblk);
}
DI int expert_of_row(const int (&off)[9], int m0) { int e = 0;
#pragma unroll
    for (int q = 1; q < 8; ++q) e = (m0 >= off[q]) ? q : e;
    return e; }
template <int L> DI void ph_f1_naive(const Params& p, const Ws& w, int bid, int nblk, unsigned char* lds) {
    if (L == 0) {
        naive_gemm<2>(w.h_(), D, MT, DFF, D, [&](int, int n0) { return WSrc{p.ffn_w1 + n0, p.ffn_w3 + n0, DFF}; },
                      [&](int m, int n, float a0, float a1) { w.gg_()[(size_t)m * DFF + n] = f2bf(siluf(a0) * a1); }, lds, bid, nblk);
    } else {
        int off[9]; moe_offsets(w, off);
        naive_gemm<2>(w.hs_(), D, off[8], DFF, D, [&](int m0, int n0) { const size_t eo = (size_t)expert_of_row(off, m0) * D * DFF; return WSrc{p.moe_w1 + eo + n0, p.moe_w3 + eo + n0, DFF}; },
                      [&](int m, int n, float a0, float a1) { w.gg_()[(size_t)m * DFF + n] = f2bf(siluf(a0) * a1); }, lds, bid, nblk);
    }
}
template <int L> DI void ph_f2_naive(const Params& p, const Ws& w, int bid, int nblk, unsigned char* lds) {
    if (L == 0) {
        naive_gemm<1>(w.gg_(), DFF, MT, D, DFF, [&](int, int n0) { return WSrc{p.ffn_w2 + n0, nullptr, D}; },
                      [&](int m, int n, float a0, float) { w.mm_()[(size_t)m * D + n] = f2bf(a0); }, lds, bid, nblk);
    } else {
        int off[9]; moe_offsets(w, off);
        naive_gemm<1>(w.gg_(), DFF, off[8], D, DFF, [&](int m0, int n0) { return WSrc{p.moe_w2 + (size_t)expert_of_row(off, m0) * DFF * D + n0, nullptr, D}; },
                      [&](int m, int n, float a0, float) { w.ys_()[(size_t)m * D + n] = f2bf(a0); }, lds, bid, nblk);
    }
}

template <int L> DI void ph_g1_naive(const Params& p, const Ws& w, int bid, int nblk, unsigned char* lds) {
    bf16_t* qt_s = (bf16_t*)lds;
    bf16_t* kt_s = (bf16_t*)(lds + 65536);
    float* A_s = (float*)(lds + 131072);
    float* pg_s = A_s;
    const int tid = threadIdx.x, d = tid >> 8, k = tid & 255;
    for (int u = bid; u < NCH * NH; u += nblk) {
        const int cg = u >> 2, h = u & 3, r0 = cg * 64;
        __syncthreads();
        for (int i = tid; i < 64 * 32; i += 512) pg_s[i] = w.pg_()[(size_t)r0 * 32 + i];
        const float* w2 = (d == 0 ? p.gate_w2_f : p.gate_w2_b) + (size_t)L * 16 * 1024 + h * 256 + k;
        float wv[16];
#pragma unroll
        for (int r = 0; r < 16; ++r) wv[r] = w2[r * 1024];
        const float bias = (d == 0 ? p.gate_b_f : p.gate_b_b)[L * 1024 + h * 256 + k];
        __syncthreads();
        float tot = 0.f;
#pragma unroll 4
        for (int t = 0; t < 64; ++t) { float xg = bias;
#pragma unroll
            for (int r = 0; r < 16; ++r) xg += pg_s[t * 32 + d * 16 + r] * wv[r];
            tot += (fminf(xg, 0.f) - log1pf(__expf(-fabsf(xg)))) * 0.0625f; }
        float cum = 0.f;
#pragma unroll 1
        for (int c = 0; c < 8; ++c) {
            bf16_t kev[8];
#pragma unroll
            for (int i = 0; i < 8; ++i) {
                const int t = d ? 63 - (c * 8 + i) : c * 8 + i;
                float xg = bias;
#pragma unroll
                for (int r = 0; r < 16; ++r) xg += pg_s[t * 32 + d * 16 + r] * wv[r];
                cum += (fminf(xg, 0.f) - log1pf(__expf(-fabsf(xg)))) * 0.0625f;
                const size_t row = (size_t)(r0 + t);
                const float q = bf2f(w.P_()[row * LDP + PQ + h * 256 + k]), kk = bf2f(w.P_()[row * LDP + PK + h * 256 + k]);
                const bf16_t qtv = f2bf(q * __expf(cum)), ktv = f2bf(kk * __expf(-cum));
                kev[i] = f2bf(kk * __expf(tot - cum));
                qt_s[(d * 64 + t) * 256 + k] = qtv; kt_s[(d * 64 + t) * 256 + k] = ktv;
                w.qt_()[((size_t)d * MT + row) * 1024 + h * 256 + k] = qtv;
                asm volatile("" ::: "memory");
            }
            const int t0 = d ? 56 - c * 8 : c * 8;
            uint4 o;
            o.x = d ? ((unsigned)kev[7] | ((unsigned)kev[6] << 16)) : ((unsigned)kev[0] | ((unsigned)kev[1] << 16));
            o.y = d ? ((unsigned)kev[5] | ((unsigned)kev[4] << 16)) : ((unsigned)kev[2] | ((unsigned)kev[3] << 16));
            o.z = d ? ((unsigned)kev[3] | ((unsigned)kev[2] << 16)) : ((unsigned)kev[4] | ((unsigned)kev[5] << 16));
            o.w = d ? ((unsigned)kev[1] | ((unsigned)kev[0] << 16)) : ((unsigned)kev[6] | ((unsigned)kev[7] << 16));
            *(uint4*)(w.ket_() + ((((size_t)d * NCH + cg) * 4 + h) * 256 + k) * 64 + t0) = o;
        }
        w.gd_()[((size_t)d * NCH + cg) * 1024 + h * 256 + k] = __expf(tot);
        __syncthreads();
        { const int t = tid >> 3, s0 = (tid & 7) * 8;
#pragma unroll 1
          for (int j = 0; j < 8; ++j) { const int s = s0 + j; float a = 0.f;
              if (s <= t) { const bf16_t* qa = qt_s + t * 256; const bf16_t* ka = kt_s + s * 256; for (int c = 0; c < 256; ++c) a += bf2f(qa[c]) * bf2f(ka[c]); }
              if (s >= t) { const bf16_t* qa = qt_s + (64 + t) * 256; const bf16_t* ka = kt_s + (64 + s) * 256; for (int c = 0; c < 256; ++c) a += bf2f(qa[c]) * bf2f(ka[c]); }
              A_s[t * 64 + s] = a; } }
        __syncthreads();
        { const int n = tid; float vc[64];
#pragma unroll
          for (int s = 0; s < 64; ++s) vc[s] = bf2f(w.P_()[(size_t)(r0 + s) * LDP + PV + h * 512 + n]);
          { uint4* dst = (uint4*)(w.vt_() + (((size_t)cg * 4 + h) * 512 + n) * 64);
#pragma unroll
            for (int c = 0; c < 8; ++c) { uint4 o4;
                o4.x = (__float_as_uint(vc[c * 8 + 0]) >> 16) | (__float_as_uint(vc[c * 8 + 1]) & 0xffff0000u); o4.y = (__float_as_uint(vc[c * 8 + 2]) >> 16) | (__float_as_uint(vc[c * 8 + 3]) & 0xffff0000u);
                o4.z = (__float_as_uint(vc[c * 8 + 4]) >> 16) | (__float_as_uint(vc[c * 8 + 5]) & 0xffff0000u); o4.w = (__float_as_uint(vc[c * 8 + 6]) >> 16) | (__float_as_uint(vc[c * 8 + 7]) & 0xffff0000u);
                dst[c] = o4; } }
          for (int t = 0; t < 64; ++t) { float o = 0.f;
#pragma unroll
              for (int s = 0; s < 64; ++s) o += A_s[t * 64 + s] * vc[s];
              w.oi_()[(size_t)(r0 + t) * D + h * 512 + n] = f2bf(o); } }
    }
}
template <int L> DI void ph_g2_naive(const Params& p, const Ws& w, int bid, int nblk, unsigned char* lds) {
    float* S = (float*)lds;
    bf16_t* qt_s = (bf16_t*)(lds + 65536);
    bf16_t* ke_s = (bf16_t*)(lds + 98304);
    float* g_s = (float*)(lds + 131072);
    const int tid = threadIdx.x, n = tid & 63, tq = tid >> 6;
    for (int u = bid; u < 256; u += nblk) {
        const int j = u & 7, d = (u >> 3) & 1, h = (u >> 4) & 3, b = u >> 6;
        __syncthreads();
        for (int i = tid; i < 256 * 64; i += 512) S[i] = 0.f;
        for (int step = 0; step < 36; ++step) {
            int cg; if (step < 4) cg = 128 + b * 4 + (d ? 3 - step : step); else { const int c = step - 4; cg = b * 32 + (d ? 31 - c : c); }
            const int r0 = cg * 64;
            __syncthreads();
#pragma unroll
            for (int i = 0; i < 4; ++i) { const int idx = tid + i * 512, t = idx >> 5, kc = idx & 31;
                *(uint4*)(qt_s + t * 256 + kc * 8) = *(const uint4*)(w.qt_() + ((size_t)d * MT + r0 + t) * 1024 + h * 256 + kc * 8); }
            { const uint4* src = (const uint4*)(w.ket_() + (((size_t)d * NCH + cg) * 4 + h) * 256 * 64);
#pragma unroll
              for (int i = 0; i < 4; ++i) ((uint4*)ke_s)[tid + i * 512] = src[tid + i * 512]; }
            if (tid < 256) g_s[tid] = w.gd_()[((size_t)d * NCH + cg) * 1024 + h * 256 + tid];
            float vc[64];
            { const uint4* src = (const uint4*)(w.vt_() + (((size_t)cg * 4 + h) * 512 + j * 64 + n) * 64);
#pragma unroll
              for (int c = 0; c < 8; ++c) { const uint4 v = src[c];
                  vc[c * 8 + 0] = __uint_as_float(v.x << 16); vc[c * 8 + 1] = __uint_as_float(v.x & 0xffff0000u); vc[c * 8 + 2] = __uint_as_float(v.y << 16); vc[c * 8 + 3] = __uint_as_float(v.y & 0xffff0000u);
                  vc[c * 8 + 4] = __uint_as_float(v.z << 16); vc[c * 8 + 5] = __uint_as_float(v.z & 0xffff0000u); vc[c * 8 + 6] = __uint_as_float(v.w << 16); vc[c * 8 + 7] = __uint_as_float(v.w & 0xffff0000u); } }
            __syncthreads();
            { float acc[8] = {0.f, 0.f, 0.f, 0.f, 0.f, 0.f, 0.f, 0.f};
              for (int kk = 0; kk < 256; ++kk) { const float s = S[kk * 64 + n];
#pragma unroll
                  for (int i = 0; i < 8; ++i) acc[i] += bf2f(qt_s[(tq * 8 + i) * 256 + kk]) * s; }
#pragma unroll
              for (int i = 0; i < 8; ++i) w.of_()[((size_t)d * MT + r0 + tq * 8 + i) * D + h * 512 + j * 64 + n] = f2bf(acc[i]); }
            __syncthreads();
            for (int i = 0; i < 32; ++i) { const int kk = tq * 32 + i; float s = g_s[kk] * S[kk * 64 + n];
#pragma unroll
                for (int t = 0; t < 64; ++t) s += bf2f(ke_s[kk * 64 + t]) * vc[t];
                S[kk * 64 + n] = s; }
        }
    }
}

#define XB_TMO      128
#define XB_XCNT(j)  (256  + 64 * (j))
#define XB_XSUB(j)  (1280 + 64 * (j))
#define XB_XGEN(j)  (2304 + 64 * (j))
#define XB_TOP      3328
#define XB_TOPGEN   3392
#define XCD_BAR_WORDS 3456
#define XB_SPIN_CAP (1u << 18)
#define LAS __attribute__((address_space(3)))

__device__ __forceinline__ unsigned xb_ld(unsigned* p)              { return __hip_atomic_load(p, __ATOMIC_RELAXED, __HIP_MEMORY_SCOPE_AGENT); }
__device__ __forceinline__ unsigned xb_add(unsigned* p, unsigned v) { return __hip_atomic_fetch_add(p, v, __ATOMIC_RELAXED, __HIP_MEMORY_SCOPE_AGENT); }
__device__ __forceinline__ unsigned xb_xcc_id() { return (unsigned)__builtin_amdgcn_s_getreg((3 << 11) | 20) & 0xFu; }
#define XB_SPIN(cond, bar) do { unsigned _sp = 0; while (cond) { __builtin_amdgcn_s_sleep(1); \
    if ((++_sp & 255u) == 0u) { if (xb_ld(&(bar)[XB_TMO])) break; if (_sp > XB_SPIN_CAP) { atomicAdd(&(bar)[XB_TMO], 1u); break; } } } } while (0)

struct XcdBarrier {
    unsigned* bar; unsigned x;
    volatile LAS unsigned* st;
};

__device__ __forceinline__ XcdBarrier xcd_barrier_post(unsigned* bar, volatile LAS unsigned* st) {
    XcdBarrier b; b.bar = bar; b.x = xb_xcc_id(); b.st = st;
    if (threadIdx.x == 0) (void)xb_add(&bar[XB_XCNT(b.x)], 1u);
    return b;
}
__device__ __forceinline__ void xcd_barrier_complete(unsigned* bar, unsigned x, unsigned& nloc, unsigned& nx) {
    const unsigned G = gridDim.x * gridDim.y * gridDim.z;
    unsigned sum, cnt, mine, sp = 0u;
    for (;;) {
        sum = 0u; cnt = 0u; mine = 0u;
#pragma unroll
        for (unsigned j = 0; j < 16; ++j) { const unsigned c = xb_ld(&bar[XB_XCNT(j)]); sum += c; cnt += (c > 0u) ? 1u : 0u; mine = (j == x) ? c : mine; }
        if (sum == G) break;
        __builtin_amdgcn_s_sleep(1);
        if ((++sp & 255u) == 0u) { if (xb_ld(&bar[XB_TMO])) break; if (sp > XB_SPIN_CAP) { atomicAdd(&bar[XB_TMO], 1u); break; } }
    }
    nloc = mine > 0u ? mine : 1u; nx = cnt > 0u ? cnt : 1u;
}

__device__ __forceinline__ void xcd_barrier(const XcdBarrier& b) {
    asm volatile("s_waitcnt vmcnt(0)" ::: "memory");
    __syncthreads();
    if (threadIdx.x == 0) {
        unsigned* bar = b.bar;
        __builtin_amdgcn_s_waitcnt(0);
        unsigned nloc = b.st[0], nx = b.st[1];
        if (nloc == 0u) { xcd_barrier_complete(bar, b.x, nloc, nx); b.st[0] = nloc; b.st[1] = nx; }
        const unsigned old = xb_add(&bar[XB_XSUB(b.x)], 1u);
        const unsigned gen = old / nloc;
        if (old + 1u == (gen + 1u) * nloc) {
            __builtin_amdgcn_fence(__ATOMIC_RELEASE, "agent");
            asm volatile("s_waitcnt vmcnt(0)" ::: "memory");
            const unsigned og = xb_add(&bar[XB_TOP], 1u);
            const unsigned tg = og / nx;
            if (og + 1u == (tg + 1u) * nx) xb_add(&bar[XB_TOPGEN], 1u);
            else XB_SPIN(xb_ld(&bar[XB_TOPGEN]) == tg, bar);
            __builtin_amdgcn_fence(__ATOMIC_ACQUIRE, "agent");
            xb_add(&bar[XB_XGEN(b.x)], 1u);
            asm volatile("s_waitcnt vmcnt(0)" ::: "memory");
        } else {
            XB_SPIN(xb_ld(&bar[XB_XGEN(b.x)]) == gen, bar);
            __builtin_amdgcn_fence(__ATOMIC_ACQUIRE, "agent");
            asm volatile("s_waitcnt vmcnt(0)" ::: "memory");
        }
    }
    __syncthreads();
}


namespace pg8 {
#define PG8_LAS __attribute__((address_space(3)))
typedef unsigned short bf16_t;
typedef short bf16x8 __attribute__((ext_vector_type(8)));
typedef float f32x4 __attribute__((ext_vector_type(4)));
typedef unsigned u32x4 __attribute__((ext_vector_type(4)));
constexpr int BM = 256, BK = 64, HALF = 128, HTB = HALF * BK * 2  , STAGE_BYTES = 8 * HTB, NXCD = 8, WGM = 8;

__host__ __device__ __forceinline__ int lds_byte(int r, int c) { const int st = (r >> 4) * 2 + (c >> 5), rr = r & 15, cc = c & 31, ob = rr * 64 + cc * 2; return st * 1024 + (ob ^ (((ob >> 9) & 1) << 5)); }
__host__ __device__ __forceinline__ void stage_rc(int b, int& R, int& C) { const int st = b / 1024, sb = b % 1024, swz = sb ^ (((sb >> 9) & 1) << 5); R = (st >> 1) * 16 + swz / 64; C = (st & 1) * 32 + (swz % 64) / 2; }
__host__ __device__ __forceinline__ int perm32(int rho) { const int n = rho >> 4, i = rho & 15; return 8 * (i >> 2) + 4 * n + (i & 3); }

struct Unit { int pm, pn, ks; };
struct Gemm { const bf16_t* A; const bf16_t* Bt; int M, N, K; };

struct StaticOrder {
    int nM, nN, nwg, G, c;
    __host__ __device__ __forceinline__ void init(int M, int N, int G_, int c_) { nM = M / BM; nN = N / BM; nwg = nM * nN; G = G_; c = c_; }
    __host__ __device__ __forceinline__ bool next(int i, Unit& u) const {
        const long L = (long)i * G + c; if (L >= nwg) return false;
        int wgid = (int)L; { const int q = nwg / NXCD, r = nwg % NXCD, xcd = wgid % NXCD, off = wgid / NXCD; wgid = (xcd < r ? xcd * (q + 1) : r * (q + 1) + (xcd - r) * q) + off; }
        const int nig = WGM * nN, gid = wgid / nig, fm = gid * WGM, gsz = (nM - fm) < WGM ? (nM - fm) : WGM;
        u.pm = fm + ((wgid % nig) % gsz); u.pn = (wgid % nig) / gsz; u.ks = -1; return true;
    }
    __device__ __forceinline__ void a_ready(const Unit&) const {}
    __device__ __forceinline__ void done(const Unit&) const {}
    __device__ __forceinline__ int koff(const Unit&) const { return 0; }
    __device__ __forceinline__ int ntiles(const Unit&, int nt_full) const { return nt_full; }
};

typedef __bf16 bf2_t __attribute__((ext_vector_type(2)));
typedef float f2_t __attribute__((ext_vector_type(2)));
__device__ __forceinline__ unsigned cvt_pk_bf16(float lo, float hi) { const f2_t f = {lo, hi}; const bf2_t b = __builtin_convertvector(f, bf2_t); return __builtin_bit_cast(unsigned, b); }
template <class Epi, class Sched, bool ALIGN_EPI = false, bool SP2 = false>
__device__ __forceinline__ void gemm_phase(PG8_LAS unsigned char* lds, const Gemm g, const Sched& S, const Epi& E) {
    const int tid = threadIdx.x, wid = __builtin_amdgcn_readfirstlane(tid >> 6), lane = tid & 63, wr = wid >> 2, wc = wid & 3, fr = lane & 15, fq = lane >> 4;
    const int K = g.K, nt_full = K / BK;
    unsigned voffA[2], voffB[2];
#pragma unroll
    for (int i = 0; i < 2; ++i) { int R, C; stage_rc(tid * 16 + i * 8192, R, C); const int Rb = Epi::PERM ? ((R & ~31) + perm32(R & 31)) : R;
        voffA[i] = (unsigned)(R * K + C) * 2u; voffB[i] = (unsigned)(Rb * K + C) * 2u; }
    const size_t kstep = (size_t)(BK * 2);
    const size_t hstep = (size_t)HALF * K * 2;
    const size_t tstep = 2 * hstep;
    const unsigned ldsw = (unsigned)wid * 1024u;
    const int aoff = lds_byte(wr * 64 + fr, fq * 8), boff = lds_byte(wc * 32 + fr, fq * 8);
#define PG8_SA(b, h) (((b) * 2 + (h)) * HTB)
#define PG8_SB(b, h) ((4 + (b) * 2 + (h)) * HTB)
#define PG8_STAGE(bufoff, gbase, voff) do { _Pragma("unroll") for (int _i = 0; _i < 2; ++_i) \
        __builtin_amdgcn_global_load_lds((const unsigned*)((const char*)(gbase) + (voff)[_i]), (PG8_LAS unsigned*)(lds + (bufoff) + ldsw + _i * 8192), 16, 0, 0); } while (0)
#define PG8_LDA(dst, b, h) do { _Pragma("unroll") for (int m = 0; m < 4; ++m) _Pragma("unroll") for (int k = 0; k < 2; ++k) dst[m][k] = *(const PG8_LAS bf16x8*)(lds + PG8_SA(b, h) + aoff + m * 2048 + k * 1024); } while (0)
#define PG8_LDB(dst, b, h) do { _Pragma("unroll") for (int n = 0; n < 2; ++n) _Pragma("unroll") for (int k = 0; k < 2; ++k) dst[n][k] = *(const PG8_LAS bf16x8*)(lds + PG8_SB(b, h) + boff + n * 2048 + k * 1024); } while (0)
#define PG8_MMA(ai, bj, At, Bt) do { __builtin_amdgcn_s_setprio(1); _Pragma("unroll") for (int m = 0; m < 4; ++m) _Pragma("unroll") for (int n = 0; n < 2; ++n) _Pragma("unroll") for (int k = 0; k < 2; ++k) \
        acc[ai][bj][m][n] = __builtin_amdgcn_mfma_f32_16x16x32_bf16(Bt[n][k], At[m][k], acc[ai][bj][m][n], 0, 0, 0); __builtin_amdgcn_s_setprio(0); } while (0)
#define PG8_WAIT_V(n) asm volatile("s_waitcnt vmcnt(" #n ")" ::: "memory")
#define PG8_WAIT_L(n) asm volatile("s_waitcnt lgkmcnt(" #n ")" ::: "memory")
#define PG8_WAIT_V8R(flag) do { \
    if constexpr (Epi::NST == 16) asm volatile("s_cmp_eq_u32 %0, 0\n\ts_cbranch_scc1 .Lwa%=\n\ts_waitcnt vmcnt(24)\n\ts_branch .Lwb%=\n.Lwa%=:\n\ts_waitcnt vmcnt(8)\n.Lwb%=:" :: "s"(flag) : "scc", "memory"); \
    else if constexpr (Epi::NST == 8) asm volatile("s_cmp_eq_u32 %0, 0\n\ts_cbranch_scc1 .Lwa%=\n\ts_waitcnt vmcnt(16)\n\ts_branch .Lwb%=\n.Lwa%=:\n\ts_waitcnt vmcnt(8)\n.Lwb%=:" :: "s"(flag) : "scc", "memory"); \
    else PG8_WAIT_V(8); } while (0)
#define PG8_BAR __builtin_amdgcn_s_barrier()
#define PG8_SCHED __builtin_amdgcn_sched_barrier(0)
    Unit cur, nxt; int ui = 0;
    if (!S.next(0, cur)) return;
    f32x4 acc[2][2][4][2];
#pragma unroll
    for (int a = 0; a < 2; ++a)
#pragma unroll
        for (int b = 0; b < 2; ++b)
#pragma unroll
            for (int m = 0; m < 4; ++m)
#pragma unroll
                for (int n = 0; n < 2; ++n) acc[a][b][m][n] = (f32x4){0.f, 0.f, 0.f, 0.f};
    bf16x8 At[4][2], B0[2][2], B1[2][2];
    const char* cA = (const char*)g.A + (size_t)cur.pm * tstep + (size_t)S.koff(cur) * 2; const char* cB = (const char*)g.Bt + (size_t)cur.pn * tstep + (size_t)S.koff(cur) * 2;
    S.a_ready(cur);
    if constexpr (SP2) {
        PG8_STAGE(PG8_SB(0, 0), cB, voffB); PG8_STAGE(PG8_SB(0, 1), cB + hstep, voffB); PG8_STAGE(PG8_SA(0, 0), cA, voffA); PG8_STAGE(PG8_SA(0, 1), cA + hstep, voffA);
        if (wr == 1) PG8_BAR;
        PG8_WAIT_V(2); PG8_BAR;
        PG8_STAGE(PG8_SB(1, 0), cB + kstep, voffB); PG8_STAGE(PG8_SA(1, 0), cA + kstep, voffA); PG8_STAGE(PG8_SB(1, 1), cB + hstep + kstep, voffB);
        PG8_WAIT_V(6); PG8_BAR;
    } else {
        PG8_STAGE(PG8_SB(0, 0), cB, voffB); PG8_STAGE(PG8_SA(0, 0), cA, voffA); PG8_STAGE(PG8_SB(0, 1), cB + hstep, voffB); PG8_STAGE(PG8_SA(0, 1), cA + hstep, voffA);
        if (wr == 1) PG8_BAR;
        PG8_WAIT_V(4); PG8_BAR;
        PG8_STAGE(PG8_SB(1, 0), cB + kstep, voffB); PG8_STAGE(PG8_SA(1, 0), cA + kstep, voffA); PG8_STAGE(PG8_SB(1, 1), cB + hstep + kstep, voffB);
        PG8_WAIT_V(6); PG8_BAR;
    }
    for (;;) {
        const bool has_next = S.next(ui + 1, nxt);
        const char* nA = has_next ? (const char*)g.A + (size_t)nxt.pm * tstep + (size_t)S.koff(nxt) * 2 : cA; const char* nB = has_next ? (const char*)g.Bt + (size_t)nxt.pn * tstep + (size_t)S.koff(nxt) * 2 : cB;
        const int nt = S.ntiles(cur, nt_full);
        for (int t = 0; t < nt; t += 2) {
            const bool last = (t == nt - 2);
            const char* a1 = cA + (size_t)(t + 1) * kstep;
            const char* a2 = last ? nA : cA + (size_t)(t + 2) * kstep; const char* b2 = last ? nB : cB + (size_t)(t + 2) * kstep;
            const char* a3 = a2 + kstep; const char* b3 = b2 + kstep;
            if (last && has_next) S.a_ready(nxt);
            if constexpr (SP2) {
            const int rflag = __builtin_amdgcn_readfirstlane((t == 0 && ui > 0) ? 1 : 0);
            PG8_LDB(B0, 0, 0); PG8_LDB(B1, 0, 1); PG8_SCHED; PG8_LDA(At, 0, 0); PG8_STAGE(PG8_SA(1, 1), a1 + hstep, voffA);
            PG8_WAIT_V8R(rflag); PG8_WAIT_L(0); PG8_BAR; PG8_MMA(0, 0, At, B0); PG8_MMA(0, 1, At, B1); PG8_BAR; PG8_SCHED;
            PG8_LDA(At, 0, 1); PG8_STAGE(PG8_SB(0, 0), b2, voffB); PG8_STAGE(PG8_SB(0, 1), b2 + hstep, voffB); PG8_STAGE(PG8_SA(0, 0), a2, voffA);
            PG8_WAIT_V8R(rflag); PG8_WAIT_L(0); PG8_BAR; PG8_MMA(1, 0, At, B0); PG8_MMA(1, 1, At, B1); PG8_BAR; PG8_SCHED;
            PG8_LDB(B0, 1, 0); PG8_LDB(B1, 1, 1); PG8_SCHED; PG8_LDA(At, 1, 0); PG8_STAGE(PG8_SA(0, 1), a2 + hstep, voffA);
            PG8_WAIT_V(8); PG8_WAIT_L(0); PG8_BAR; PG8_MMA(0, 0, At, B0); PG8_MMA(0, 1, At, B1); PG8_BAR; PG8_SCHED;
            PG8_LDA(At, 1, 1); PG8_STAGE(PG8_SB(1, 0), b3, voffB); PG8_STAGE(PG8_SB(1, 1), b3 + hstep, voffB); PG8_STAGE(PG8_SA(1, 0), a3, voffA);
            PG8_WAIT_V(8); PG8_WAIT_L(0); PG8_BAR; PG8_MMA(1, 0, At, B0); PG8_MMA(1, 1, At, B1); PG8_BAR; PG8_SCHED;
            } else {
            PG8_LDB(B0, 0, 0); PG8_SCHED; PG8_LDA(At, 0, 0); PG8_STAGE(PG8_SA(1, 1), a1 + hstep, voffA);
            PG8_WAIT_L(8); PG8_BAR; PG8_WAIT_L(0); PG8_MMA(0, 0, At, B0); PG8_BAR; PG8_SCHED;
            PG8_LDB(B1, 0, 1); PG8_STAGE(PG8_SB(0, 0), b2, voffB);
            PG8_BAR; PG8_WAIT_L(0); PG8_MMA(0, 1, At, B1); PG8_BAR;
            PG8_LDA(At, 0, 1); PG8_STAGE(PG8_SA(0, 0), a2, voffA);
            PG8_BAR; PG8_WAIT_L(0); PG8_MMA(1, 0, At, B0); PG8_BAR; PG8_SCHED;
            PG8_STAGE(PG8_SB(0, 1), b2 + hstep, voffB);
            PG8_WAIT_V(6); PG8_BAR; PG8_MMA(1, 1, At, B1); PG8_BAR;
            PG8_LDB(B0, 1, 0); PG8_SCHED; PG8_LDA(At, 1, 0); PG8_STAGE(PG8_SA(0, 1), a2 + hstep, voffA);
            PG8_WAIT_L(8); PG8_BAR; PG8_WAIT_L(0); PG8_MMA(0, 0, At, B0); PG8_BAR; PG8_SCHED;
            PG8_LDB(B1, 1, 1); PG8_STAGE(PG8_SB(1, 0), b3, voffB);
            PG8_BAR; PG8_WAIT_L(0); PG8_MMA(0, 1, At, B1); PG8_BAR;
            PG8_LDA(At, 1, 1); PG8_STAGE(PG8_SA(1, 0), a3, voffA);
            PG8_BAR; PG8_WAIT_L(0); PG8_MMA(1, 0, At, B0); PG8_BAR; PG8_SCHED;
            PG8_STAGE(PG8_SB(1, 1), b3 + hstep, voffB);
            PG8_WAIT_V(6); PG8_BAR; PG8_MMA(1, 1, At, B1); PG8_BAR;
            }
        }
        if constexpr (ALIGN_EPI) { if (wr == 0) PG8_BAR; }
        if constexpr (!Epi::AFTER_DRAIN) { E(acc, cur, wr, wc, fr, fq); S.done(cur); }
        if (!has_next) break;
#pragma unroll
        for (int a = 0; a < 2; ++a)
#pragma unroll
            for (int b = 0; b < 2; ++b)
#pragma unroll
                for (int m = 0; m < 4; ++m)
#pragma unroll
                    for (int n = 0; n < 2; ++n) acc[a][b][m][n] = (f32x4){0.f, 0.f, 0.f, 0.f};
        cur = nxt; cA = nA; cB = nB; ++ui;
        if constexpr (ALIGN_EPI) { if (wr == 1) PG8_BAR; }
    }
    PG8_WAIT_V(0);
    if constexpr (!ALIGN_EPI) { if (wr == 0) PG8_BAR; }
    PG8_BAR;
    if constexpr (Epi::AFTER_DRAIN) { E.fused(acc, cur, wr, wc, fr, fq, lds, wid, lane); S.done(cur); }
#undef PG8_SA
#undef PG8_SB
#undef PG8_STAGE
#undef PG8_LDA
#undef PG8_LDB
#undef PG8_MMA
#undef PG8_WAIT_V
#undef PG8_WAIT_L
#undef PG8_BAR
#undef PG8_SCHED
}
}

using pg8::Unit; using pg8::Gemm;
typedef unsigned u32x4 __attribute__((ext_vector_type(4)));
typedef unsigned u32x2 __attribute__((ext_vector_type(2)));
DI float fsig(float v) { return __builtin_amdgcn_rcpf(1.f + __expf(-v)); }
DI f32x4 unpack4(u32x2 g) { return (f32x4){__uint_as_float(g.x << 16), __uint_as_float(g.x & 0xffff0000u), __uint_as_float(g.y << 16), __uint_as_float(g.y & 0xffff0000u)}; }

struct RectOrder : pg8::StaticOrder {
    int xM, xN, xwg;
    DI void init2(int M, int N, int G_, int c_, int xM_, int xN_) { init(M, N, G_, c_); xM = xM_; xN = xN_; xwg = xM_ * xN_; }
    DI bool next(int i, Unit& u) const {
        const long Lx = (long)i * G + c;
        if (Lx < nwg) return pg8::StaticOrder::next(i, u);
        if (Lx >= nwg + xwg) return false;
        const int l2 = (int)(Lx - nwg); u.pm = nM + l2 % xM; u.pn = l2 / xM; u.ks = -1; return true;
    }
};
struct SplitOrder : pg8::StaticOrder {
    int xM, xwg, kq;
    DI void init2(int M, int N, int G_, int c_, int xM_, int K) { init(M, N, G_, c_); xM = xM_; xwg = xM_ * nN * 4; kq = K / 4; }
    DI bool next(int i, Unit& u) const {
        const long Lx = (long)i * G + c;
        if (Lx < nwg) return pg8::StaticOrder::next(i, u);
        if (Lx >= nwg + xwg) return false;
        const int l2 = (int)(Lx - nwg), sl = l2 & 3, tile = l2 >> 2; u.pm = nM + tile % xM; u.pn = tile / xM; u.ks = sl; return true;
    }
    DI int koff(const Unit& u) const { return u.ks < 0 ? 0 : u.ks * kq; }
    DI int ntiles(const Unit& u, int nt_full) const { return u.ks < 0 ? nt_full : kq / 64; }
};
template <bool SPLIT> struct MoeOrderT : SplitOrder {
    const LAS unsigned char* pe;
    DI bool next(int i, Unit& u) const { if (SPLIT ? !SplitOrder::next(i, u) : !pg8::StaticOrder::next(i, u)) return false; u.pn += (int)pe[u.pm] * nN; return true; }
};
typedef MoeOrderT<false> MoeOrder;

struct EpiInproj {
    static constexpr bool PERM = true, AFTER_DRAIN = false; static constexpr int NST = 8;
    bf16_t* P;
    DI void operator()(const f32x4 (&acc)[2][2][4][2], const Unit& u, int wr, int wc, int fr, int fq) const {
        const int pn = u.pn, row0 = u.pm * 256 + wr * 64 + fr;
        if (pn >= 32 && pn < 48) {
            const int col = PU + 128 * (pn - 32) + wc * 32 + 8 * fq;
#pragma unroll
            for (int ai = 0; ai < 2; ++ai)
#pragma unroll
                for (int m = 0; m < 4; ++m) { const f32x4 v0 = acc[ai][0][m][0] * acc[ai][1][m][0], v1 = acc[ai][0][m][1] * acc[ai][1][m][1];
                    u32x4 o; o.x = pg8::cvt_pk_bf16(v0[0], v0[1]); o.y = pg8::cvt_pk_bf16(v0[2], v0[3]); o.z = pg8::cvt_pk_bf16(v1[0], v1[1]); o.w = pg8::cvt_pk_bf16(v1[2], v1[3]);
                    *(u32x4*)(P + (size_t)(row0 + ai * 128 + m * 16) * LDP + col) = o; }
        } else {
            const int col = (pn < 32 ? 256 * pn : 256 * (pn - 8)) + wc * 32 + 8 * fq;
            const int act = (pn >= 16 && pn < 24) ? 1 : (pn >= 48 ? 2 : 0);
#pragma unroll
            for (int ai = 0; ai < 2; ++ai)
#pragma unroll
                for (int m = 0; m < 4; ++m)
#pragma unroll
                    for (int bj = 0; bj < 2; ++bj) { f32x4 v0 = acc[ai][bj][m][0], v1 = acc[ai][bj][m][1];
                        if (act) {
#pragma unroll
                            for (int j = 0; j < 4; ++j) { const float s0 = fsig(v0[j]), s1 = fsig(v1[j]); v0[j] = act == 1 ? v0[j] * s0 : s0; v1[j] = act == 1 ? v1[j] * s1 : s1; } }
                        u32x4 o; o.x = pg8::cvt_pk_bf16(v0[0], v0[1]); o.y = pg8::cvt_pk_bf16(v0[2], v0[3]); o.z = pg8::cvt_pk_bf16(v1[0], v1[1]); o.w = pg8::cvt_pk_bf16(v1[2], v1[3]);
                        *(u32x4*)(P + (size_t)(row0 + ai * 128 + m * 16) * LDP + col + bj * 128) = o; }
        }
    }
};
DI u32x4 pack8(const f32x4 v0, const f32x4 v1) { u32x4 o; o.x = pg8::cvt_pk_bf16(v0[0], v0[1]); o.y = pg8::cvt_pk_bf16(v0[2], v0[3]); o.z = pg8::cvt_pk_bf16(v1[0], v1[1]); o.w = pg8::cvt_pk_bf16(v1[2], v1[3]); return o; }
struct EpiGateA {
    static constexpr bool PERM = true, AFTER_DRAIN = false; static constexpr int NST = 16;
    bf16_t* out; const bf16_t* P; int gcol;
    DI void operator()(const f32x4 (&acc)[2][2][4][2], const Unit& u, int wr, int wc, int fr, int fq) const {
        const int row0 = u.pm * 256 + wr * 64 + fr, col0 = u.pn * 256 + wc * 32 + 8 * fq;
#pragma unroll
        for (int ai = 0; ai < 2; ++ai)
#pragma unroll
            for (int m = 0; m < 4; ++m) { const size_t r = (size_t)(row0 + ai * 128 + m * 16);
#pragma unroll
                for (int bj = 0; bj < 2; ++bj) { const int c = col0 + bj * 128; const u32x4 gq = *(const u32x4*)(P + r * LDP + gcol + c);
                    *(u32x4*)(out + r * D + c) = pack8(acc[ai][bj][m][0] * unpack4((u32x2){gq.x, gq.y}), acc[ai][bj][m][1] * unpack4((u32x2){gq.z, gq.w})); } }
    }
};
struct EpiGateB {
    static constexpr bool PERM = true, AFTER_DRAIN = false; static constexpr int NST = 16;
    bf16_t* out; const bf16_t* ma; const bf16_t* P; int gcol;
    DI void operator()(const f32x4 (&acc)[2][2][4][2], const Unit& u, int wr, int wc, int fr, int fq) const {
        const int row0 = u.pm * 256 + wr * 64 + fr, col0 = u.pn * 256 + wc * 32 + 8 * fq;
#pragma unroll
        for (int ai = 0; ai < 2; ++ai)
#pragma unroll
            for (int m = 0; m < 4; ++m) { const size_t r = (size_t)(row0 + ai * 128 + m * 16);
#pragma unroll
                for (int bj = 0; bj < 2; ++bj) { const int c = col0 + bj * 128;
                    const u32x4 gq = *(const u32x4*)(P + r * LDP + gcol + c), aq = *(const u32x4*)(ma + r * D + c);
                    const f32x4 v0 = unpack4((u32x2){aq.x, aq.y}) + acc[ai][bj][m][0] * unpack4((u32x2){gq.x, gq.y}), v1 = unpack4((u32x2){aq.z, aq.w}) + acc[ai][bj][m][1] * unpack4((u32x2){gq.z, gq.w});
                    *(u32x4*)(out + r * D + c) = pack8(v0, v1); } }
    }
};
struct EpiF32 {
    static constexpr bool PERM = true, AFTER_DRAIN = false; static constexpr int NST = 16;
    bf16_t* out; float* part; int row0p, prows;
    DI void operator()(const f32x4 (&acc)[2][2][4][2], const Unit& u, int wr, int wc, int fr, int fq) const {
        const int row0 = u.pm * 256 + wr * 64 + fr, col0 = (u.pn & 7) * 256 + wc * 32 + 8 * fq;
        if (u.ks < 0) {
#pragma unroll
            for (int ai = 0; ai < 2; ++ai)
#pragma unroll
                for (int m = 0; m < 4; ++m)
#pragma unroll
                    for (int bj = 0; bj < 2; ++bj) *(u32x4*)(out + (size_t)(row0 + ai * 128 + m * 16) * D + col0 + bj * 128) = pack8(acc[ai][bj][m][0], acc[ai][bj][m][1]);
        } else {
            float* base = part + ((size_t)u.ks * prows + (row0 - row0p)) * D + col0;
#pragma unroll
            for (int ai = 0; ai < 2; ++ai)
#pragma unroll
                for (int m = 0; m < 4; ++m)
#pragma unroll
                    for (int bj = 0; bj < 2; ++bj) { float* rp = base + (size_t)(ai * 128 + m * 16) * D + bj * 128; *(f32x4*)rp = acc[ai][bj][m][0]; *(f32x4*)(rp + 4) = acc[ai][bj][m][1]; }
        }
    }
};
struct EpiSwiglu {
    static constexpr bool PERM = true, AFTER_DRAIN = false; static constexpr int NST = 8;
    bf16_t* out;
    DI void operator()(const f32x4 (&acc)[2][2][4][2], const Unit& u, int wr, int wc, int fr, int fq) const {
        const int row0 = u.pm * 256 + wr * 64 + fr, col = (u.pn % 44) * 128 + wc * 32 + 8 * fq;
#pragma unroll
        for (int ai = 0; ai < 2; ++ai)
#pragma unroll
            for (int m = 0; m < 4; ++m) { f32x4 v0, v1;
#pragma unroll
                for (int j = 0; j < 4; ++j) { const float a0 = acc[ai][0][m][0][j], a1 = acc[ai][0][m][1][j]; v0[j] = a0 * fsig(a0) * acc[ai][1][m][0][j]; v1[j] = a1 * fsig(a1) * acc[ai][1][m][1][j]; }
                u32x4 o; o.x = pg8::cvt_pk_bf16(v0[0], v0[1]); o.y = pg8::cvt_pk_bf16(v0[2], v0[3]); o.z = pg8::cvt_pk_bf16(v1[0], v1[1]); o.w = pg8::cvt_pk_bf16(v1[2], v1[3]);
                *(u32x4*)(out + (size_t)(row0 + ai * 128 + m * 16) * DFF + col) = o; }
    }
};

DI void conv_tile(const float* __restrict__ src, int ld, bf16_t* __restrict__ dst, int K, int k0, float scale, float* tile  ) {
    const int tid = threadIdx.x;
    __syncthreads();
#pragma unroll
    for (int ps = 0; ps < 4; ++ps) { const int kr = ps * 32 + (tid >> 4), c4 = (tid & 15) * 4;
        const float4 v = *(const float4*)(src + (size_t)(k0 + kr) * ld + c4);
        float* t = tile + kr * 65 + c4; t[0] = v.x; t[1] = v.y; t[2] = v.z; t[3] = v.w; }
    __syncthreads();
#pragma unroll
    for (int ps = 0; ps < 2; ++ps) { const int n = ps * 32 + (tid >> 4), kc = (tid & 15) * 8; const float* t = tile + kc * 65 + n;
        u32x4 o; o.x = pg8::cvt_pk_bf16(t[0] * scale, t[65] * scale); o.y = pg8::cvt_pk_bf16(t[130] * scale, t[195] * scale);
        o.z = pg8::cvt_pk_bf16(t[260] * scale, t[325] * scale); o.w = pg8::cvt_pk_bf16(t[390] * scale, t[455] * scale);
        *(u32x4*)(dst + (size_t)n * K + k0 + kc) = o; }
}
DI int win_src_col(int vn) {
    if (vn < 4096) return vn;
    if (vn < 6144) return OFF_R + vn - 4096;
    if (vn < 8192) return OFF_CB + vn - 6144;
    if (vn < 12288) { const int t = (vn - 8192) >> 8, wi = (vn - 8192) & 255; return wi < 128 ? OFF_CC + 128 * t + wi : OFF_CX + 128 * t + wi - 128; }
    if (vn < 14336) return OFF_GA + vn - 12288;
    return OFF_GB + vn - 14336;
}
struct CT { const float* src; bf16_t* dst; int ld, K, k0; float scale; };
constexpr int DT_D0 = 0, DT_D1 = DT_D0 + 1536, DT_D1B = DT_D1 + 2816, DT_D2 = DT_D1B + 1408, DT_D2B = DT_D2 + 4096, DT_D2C = DT_D2B + 16, DT_D3 = DT_D2C + 1536, DT_D3B = DT_D3 + 8 * 2816, DT_END = DT_D3B + 8 * 1408;
DI CT conv_sq(const Params& p, unsigned char* ws, int l, int u) {
    const int kt = u & 15, g = (u >> 4) & 31, which = u >> 9;
    const float* src = (which == 0 ? p.w_proj_a : which == 1 ? p.w_proj_b : p.w_out) + (size_t)l * D * D + g * 64;
    bf16_t* dst = (bf16_t*)(ws + (which == 0 ? WS_WA : which == 1 ? WS_WB : WS_WO)) + ((size_t)l * D + g * 64) * D;
    return CT{src, dst, D, D, kt * 128, 1.f};
}
DI CT conv_up(const Params& p, unsigned char* ws, int e, int u) {
    const int kt = u & 15, g = u >> 4, t = (g * 64) >> 8, wi = (g * 64) & 255;
    const float* w1 = e == 8 ? p.ffn_w1 : p.moe_w1 + (size_t)e * D * DFF; const float* w3 = e == 8 ? p.ffn_w3 : p.moe_w3 + (size_t)e * D * DFF;
    const float* src = wi < 128 ? w1 + 128 * t + wi : w3 + 128 * t + wi - 128;
    bf16_t* dst = (e == 8 ? (bf16_t*)(ws + WS_F1) : (bf16_t*)(ws + WS_M1) + (size_t)e * 11264 * D) + (size_t)g * 64 * D;
    return CT{src, dst, DFF, D, kt * 128, 1.f};
}
DI CT conv_down(const Params& p, unsigned char* ws, int e, int u) {
    const int kt = u % 44, g = u / 44;
    const float* src = (e == 8 ? p.ffn_w2 : p.moe_w2 + (size_t)e * DFF * D) + g * 64;
    bf16_t* dst = (e == 8 ? (bf16_t*)(ws + WS_F2) : (bf16_t*)(ws + WS_M2) + (size_t)e * D * DFF) + (size_t)g * 64 * DFF;
    return CT{src, dst, D, DFF, kt * 128, 1.f};
}
DI CT conv_win(const Params& p, unsigned char* ws, int l, int u) {
    const int kt = u & 15, g = u >> 4;
    return CT{p.w_in + (size_t)l * D * NIN + win_src_col(g * 64), (bf16_t*)(ws + WS_WIN) + ((size_t)l * 16384 + g * 64) * D, NIN, D, kt * 128, g < 16 ? 0.0625f : 1.f};
}
DI CT conv_wg(const Params& p, unsigned char* ws, int l, int u) { return CT{p.w_in + (size_t)l * D * NIN + OFF_AF, (bf16_t*)(ws + WS_WG) + (size_t)l * 64 * D, NIN, D, (u & 15) * 128, 1.f}; }
DI CT conv_deferred(const Params& p, unsigned char* ws, int i) {
    if (i < DT_D1) return conv_sq(p, ws, 0, i - DT_D0);
    if (i < DT_D1B) return conv_up(p, ws, 8, i - DT_D1);
    if (i < DT_D2) return conv_down(p, ws, 8, i - DT_D1B);
    if (i < DT_D2B) return conv_win(p, ws, 1, i - DT_D2);
    if (i < DT_D2C) return conv_wg(p, ws, 1, i - DT_D2B);
    if (i < DT_D3) return conv_sq(p, ws, 1, i - DT_D2C);
    if (i < DT_D3B) { const int u = i - DT_D3; return conv_up(p, ws, u / 2816, u % 2816); }
    const int u = i - DT_D3B; return conv_down(p, ws, u / 1408, u % 1408);
}
struct CReg { float4 v[4]; };
DI void conv_load(const CT& c, CReg& r) { const int tid = threadIdx.x;
#pragma unroll
    for (int ps = 0; ps < 4; ++ps) { const f32x4 t = __builtin_nontemporal_load((const f32x4*)(c.src + (size_t)(c.k0 + ps * 32 + (tid >> 4)) * c.ld + (tid & 15) * 4)); r.v[ps] = make_float4(t[0], t[1], t[2], t[3]); } }
DI void conv_to_lds(const CReg& r, float* tile) { const int tid = threadIdx.x;
#pragma unroll
    for (int ps = 0; ps < 4; ++ps) { float* t = tile + (ps * 32 + (tid >> 4)) * 65 + (tid & 15) * 4; t[0] = r.v[ps].x; t[1] = r.v[ps].y; t[2] = r.v[ps].z; t[3] = r.v[ps].w; } }
DI void conv_out(const CT& c, const float* tile) { const int tid = threadIdx.x;
#pragma unroll
    for (int ps = 0; ps < 2; ++ps) { const int n = ps * 32 + (tid >> 4), kc = (tid & 15) * 8; const float* t = tile + kc * 65 + n; const float sc = c.scale;
        u32x4 o; o.x = pg8::cvt_pk_bf16(t[0] * sc, t[65] * sc); o.y = pg8::cvt_pk_bf16(t[130] * sc, t[195] * sc); o.z = pg8::cvt_pk_bf16(t[260] * sc, t[325] * sc); o.w = pg8::cvt_pk_bf16(t[390] * sc, t[455] * sc);
        __builtin_nontemporal_store(o, (u32x4*)(c.dst + (size_t)n * c.K + c.k0 + kc)); } }
template <class F> DI void conv_stream(F desc, int begin, int end, int rank, int nshare, unsigned char* ldsb) {
    float* t0 = (float*)ldsb; float* t1 = t0 + 128 * 65;
    const int first = begin + rank; if (first >= end) return;
    const int n = (end - first + nshare - 1) / nshare;
    auto idx = [&](int j) { return first + (j < n ? j : n - 1) * nshare; };
#ifndef CONVREP
#define CONVREP 1
#endif
    for (int crep = 0; crep < CONVREP; ++crep) {
    CReg ra, rb; CT ca = desc(idx(0)), cb = desc(idx(1)); conv_load(ca, ra); conv_load(cb, rb);
    __syncthreads();
#pragma unroll 1
    for (int j = 0; j < n; j += 2) {
        conv_to_lds(ra, t0); const CT oa = ca; ca = desc(idx(j + 2)); conv_load(ca, ra);
        __syncthreads();
        conv_out(oa, t0);
        conv_to_lds(rb, t1); const CT ob = cb; cb = desc(idx(j + 3)); conv_load(cb, rb);
        __syncthreads();
        if (j + 1 < n) conv_out(ob, t1);
    }
    __syncthreads();
    }
}
DI void ph_convert(const Params& p, unsigned char* ws, int bid, int nblk, unsigned char* ldsb) {
    conv_stream([&](int i) { return i < 4096 ? conv_win(p, ws, 0, i) : conv_wg(p, ws, 0, i - 4096); }, 0, 4096 + 16, bid, nblk, ldsb);
}
#ifndef SLOT_T58
#define SLOT_T58 24
#endif
#ifndef SLOT_G2
#define SLOT_G2 88
#endif
#ifndef SLOT_G1
#define SLOT_G1 7
#endif
constexpr int NSLOT = 10;
constexpr int SLOT_N[NSLOT] = {192 * SLOT_G1, 128 * SLOT_G2, 224 * SLOT_T58, 224 * SLOT_T58, 128 * (SLOT_T58 * 14 / 58), 208 * SLOT_T58, 128 * (SLOT_T58 * 33 / 58), 192 * SLOT_T58, 192 * SLOT_G1, 128 * SLOT_G2};
constexpr int slot_begin(int s) { int b = 0; for (int i = 0; i < s; ++i) b += SLOT_N[i]; return b < DT_END ? b : DT_END; }
static_assert(slot_begin(2) >= DT_D1, "w_proj_a/b, w_out of layer 0 must be converted before proj-a L0");
static_assert(slot_begin(5) >= DT_D2, "the dense FFN weights must be converted before FFN-up L0");
static_assert(slot_begin(7) >= DT_D3, "layer-1 in-projection / projection weights must be converted before in-proj L1");
DI void conv_slot(const Params& p, int s_begin, int s_end, int total, int bid, int nblk, unsigned char* ldsb) {
    if (!(FAST & FB_CONV) || s_begin >= s_end) return;
    const int rem = total % nblk;
    int rank, nshare; if (rem == 0) { rank = bid; nshare = nblk; } else { if (bid < rem) return; rank = bid - rem; nshare = nblk - rem; }
    conv_stream([&](int i) { return conv_deferred(p, p.ws, i); }, s_begin, s_end, rank, nshare, ldsb);
}
DI void conv_slot_direct(const Params& p, int s_begin, int s_end, int rank, int nshare, unsigned char* ldsb) {
    if (!(FAST & FB_CONV) || s_begin >= s_end || nshare <= 0) return;
    conv_stream([&](int i) { return conv_deferred(p, p.ws, i); }, s_begin, s_end, rank, nshare, ldsb);
}
#define CONV_SLOT(s, total) conv_slot(p, slot_begin(s), slot_begin((s) + 1), (total), bid, nblk, lds)

template <int L> DI void ph_gate_fast(const Ws& w, int bid, int nblk) {
    const int lane = threadIdx.x & 63, wave = threadIdx.x >> 6, fr = lane & 15, fq = lane >> 4;
    const bf16_t* wg = (const bf16_t*)(w.b + WS_WG) + (size_t)L * 64 * D;
    for (int t = wave * nblk + bid; t < MT / 16; t += 8 * nblk) {
        f32x4 a0 = {0.f, 0.f, 0.f, 0.f}, a1 = {0.f, 0.f, 0.f, 0.f};
        const bf16_t* ap = w.h_() + (size_t)(t * 16 + fr) * D + fq * 8; const bf16_t* bp0 = wg + (size_t)fr * D + fq * 8; const bf16_t* bp1 = bp0 + 16 * D;
#pragma unroll 8
        for (int k0 = 0; k0 < D; k0 += 32) { const pg8::bf16x8 a = *(const pg8::bf16x8*)(ap + k0), b0 = *(const pg8::bf16x8*)(bp0 + k0), b1 = *(const pg8::bf16x8*)(bp1 + k0);
            a0 = __builtin_amdgcn_mfma_f32_16x16x32_bf16(a, b0, a0, 0, 0, 0); a1 = __builtin_amdgcn_mfma_f32_16x16x32_bf16(a, b1, a1, 0, 0, 0); }
#pragma unroll
        for (int j = 0; j < 4; ++j) { float* o = w.pg_() + (size_t)(t * 16 + 4 * fq + j) * 32; o[fr] = a0[j]; o[16 + fr] = a1[j]; }
    }
}

#define GLDS(lds) ((LAS unsigned char*)(lds))
template <int L> DI void ph_inproj_fast(const Params& p, const Ws& w, int bid, int nblk, unsigned char* lds) {
    Gemm g{w.h_(), (const bf16_t*)(w.b + WS_WIN) + (size_t)L * 16384 * D, MT, 16384, D};
    RectOrder S; if (L == 0) S.init2(MT, 16384, nblk, bid, 0, 0); else S.init2(ML, 16384, nblk, bid, MC / 256, 16);
    EpiInproj E{w.P_()};
    pg8::gemm_phase<EpiInproj, RectOrder, true, true>(GLDS(lds), g, S, E);
    ph_gate_fast<L>(w, bid, nblk);
    if (L == 1) CONV_SLOT(7, 2048 + 64);
}
template <int L> DI void ph_pa_fast(const Params& p, const Ws& w, int bid, int nblk, unsigned char* lds) {
    constexpr int MR = L == 0 ? MT : ML;
    Gemm g{w.ya_(), (const bf16_t*)(w.b + WS_WA) + (size_t)L * D * D, MR, D, D}; pg8::StaticOrder S; S.init(MR, D, nblk, bid);
    EpiGateA E{w.ma_(), w.P_(), PGA};
    pg8::gemm_phase<EpiGateA, pg8::StaticOrder, true, true>(GLDS(lds), g, S, E);
    if (L == 0) CONV_SLOT(2, 288);
}
template <int L> DI void ph_pb_fast(const Params& p, const Ws& w, int bid, int nblk, unsigned char* lds) {
    constexpr int MR = L == 0 ? MT : ML;
    Gemm g{w.obr_(), (const bf16_t*)(w.b + WS_WB) + (size_t)L * D * D, MR, D, D}; pg8::StaticOrder S; S.init(MR, D, nblk, bid);
    EpiGateB E{w.mrg_(), w.ma_(), w.P_(), PGB};
    pg8::gemm_phase<EpiGateB, pg8::StaticOrder, true, true>(GLDS(lds), g, S, E);
    if (L == 0) CONV_SLOT(3, 288);
}
template <int L> DI void ph_wo_fast(const Params& p, const Ws& w, int bid, int nblk, unsigned char* lds) {
    Gemm g{w.mrg_(), (const bf16_t*)(w.b + WS_WO) + (size_t)L * D * D, L == 0 ? MT : ML, D, D};
    SplitOrder S; S.init2(ML, D, nblk, bid, L == 0 ? MC / 256 : 0, D);
    EpiF32 E{w.mm_(), (float*)(w.b + WS_MMP), ML, MC};
    pg8::gemm_phase<EpiF32, SplitOrder, true, true>(GLDS(lds), g, S, E);
    if (L == 0) CONV_SLOT(4, 256 + 128);
}
DI const LAS unsigned char* moe_panel_table(const Ws& w, unsigned char* lds, int& npanels) {
    int off[9]; moe_offsets(w, off); npanels = off[8] >> 8;
    LAS unsigned char* pe = (LAS unsigned char*)(lds + 131072 + 1024);
    __syncthreads();
    if (threadIdx.x < 80) { const int m0 = (int)threadIdx.x * 256; pe[threadIdx.x] = (unsigned char)expert_of_row(off, m0); }
    __syncthreads();
    return pe;
}
template <int L> DI void ph_f1_fast(const Params& p, const Ws& w, int bid, int nblk, unsigned char* lds) {
    if (L == 0) {
        Gemm g{w.h_(), (const bf16_t*)(w.b + WS_F1), MT, 11264, D}; pg8::StaticOrder S; S.init(MT, 11264, nblk, bid);
        EpiSwiglu E{w.gg_()};
        pg8::gemm_phase<EpiSwiglu, pg8::StaticOrder, true, true>(GLDS(lds), g, S, E);
        CONV_SLOT(5, 36 * 44);
    } else {
        int np; const LAS unsigned char* pe = moe_panel_table(w, lds, np);
        Gemm g{w.hs_(), (const bf16_t*)(w.b + WS_M1), np * 256, 11264, D}; MoeOrder S; S.init(np * 256, 11264, nblk, bid); S.pe = pe;
        EpiSwiglu E{w.gg_()};
        pg8::gemm_phase<EpiSwiglu, MoeOrder, true, true>(GLDS(lds), g, S, E);
    }
}
template <int L> DI void ph_f2_fast(const Params& p, const Ws& w, int bid, int nblk, unsigned char* lds) {
    if (L == 0) {
        Gemm g{w.gg_(), (const bf16_t*)(w.b + WS_F2), MT, D, DFF}; SplitOrder S; S.init2(ML, D, nblk, bid, MC / 256, DFF);
        EpiF32 E{w.mm_(), (float*)(w.b + WS_MMP), ML, MC};
        pg8::gemm_phase<EpiF32, SplitOrder, true, true>(GLDS(lds), g, S, E);
        CONV_SLOT(6, 256 + 128);
    } else {
        int np; const LAS unsigned char* pe = moe_panel_table(w, lds, np);
        Gemm g{w.gg_(), (const bf16_t*)(w.b + WS_M2), np * 256, D, DFF}; MoeOrderT<true> S; S.init2(64 * 256, D, nblk, bid, np - 64, DFF); S.pe = pe;
        EpiF32 E{w.ys_(), (float*)(w.b + WS_YSP), 64 * 256, 2048};
        pg8::gemm_phase<EpiF32, MoeOrderT<true>, true, true>(GLDS(lds), g, S, E);
    }
}

typedef pg8::bf16x8 bf16x8;
typedef short s16x4 __attribute__((ext_vector_type(4)));
DI bf16x8 ldg8(const bf16_t* p) { return *(const bf16x8*)p; }
DI bf16x8 lds8(const LAS unsigned char* p) { return *(const LAS bf16x8*)p; }
#define MFMA16(a, b, c) __builtin_amdgcn_mfma_f32_16x16x32_bf16((a), (b), (c), 0, 0, 0)
DI bf16x8 lds_tr8(const LAS unsigned char* img, int pitch, int lane) {
#if defined(__HIP_DEVICE_COMPILE__)
    const int g = lane >> 4, q = (lane & 15) >> 2, pp = lane & 3;
    const LAS unsigned char* a = img + (8 * g + q) * pitch + 8 * pp;
    const s16x4 lo = __builtin_amdgcn_ds_read_tr16_b64_v4i16((LAS s16x4*)a), hi = __builtin_amdgcn_ds_read_tr16_b64_v4i16((LAS s16x4*)(a + 4 * pitch));
    return __builtin_shufflevector(lo, hi, 0, 1, 2, 3, 4, 5, 6, 7);
#else
    return bf16x8{};
#endif
}
DI u32x4 lds_ld16(const LAS unsigned char* p) {
#if defined(__HIP_DEVICE_COMPILE__)
    return *(const LAS u32x4*)p;
#else
    return u32x4{};
#endif
}
DI void lds_st16(LAS unsigned char* p, u32x4 v) {
#if defined(__HIP_DEVICE_COMPILE__)
    *(LAS u32x4*)p = v;
#endif
}
DI void lds_st8(LAS unsigned char* p, u32x2 v) {
#if defined(__HIP_DEVICE_COMPILE__)
    *(LAS u32x2*)p = v;
#endif
}

DI float lsig2(float x) { const float y = x * 1.44269504f; return (fminf(y, 0.f) - __builtin_amdgcn_logf(1.f + __builtin_amdgcn_exp2f(-fabsf(y)))) * 0.0625f; }
template <int L> DI void ph_g1_fast(const Params& p, const Ws& w, int bid, int nblk, unsigned char* ldsb) {
    constexpr int RS = 544, QT_OFF = 0, KT_OFF = 2 * 64 * RS, A_OFF = 4 * 64 * RS, ARS = 144, VRS = 144;
    LAS unsigned char* lds = (LAS unsigned char*)ldsb;
    float* pg_s = (float*)(ldsb + A_OFF);
    const int tid = threadIdx.x, d = tid >> 8, k = tid & 255, lane = tid & 63, wv = tid >> 6, fr = lane & 15, fq = lane >> 4;
    for (int u = bid; u < NCH * NH; u += nblk) {
        const int cg = u >> 2, h = u & 3, r0 = cg * 64;
        __syncthreads();
        for (int i = tid; i < 64 * 32; i += 512) pg_s[i] = w.pg_()[(size_t)r0 * 32 + i];
        const int kw = (wv & 3) * 64;
        const float* w2 = (d == 0 ? p.gate_w2_f : p.gate_w2_b) + (size_t)L * 16 * 1024 + h * 256 + kw;
        const float* bv = (d == 0 ? p.gate_b_f : p.gate_b_b) + L * 1024 + h * 256 + kw;
        s16x4 bw[4]; float bias4[4];
#pragma unroll
        for (int kb = 0; kb < 4; ++kb) { const float* c0 = w2 + (4 * fq) * 1024 + 16 * kb + fr;
            const unsigned lo = pg8::cvt_pk_bf16(c0[0], c0[1024]), hi = pg8::cvt_pk_bf16(c0[2048], c0[3072]);
            bw[kb] = __builtin_bit_cast(s16x4, (u32x2){lo, hi}); bias4[kb] = bv[16 * kb + fr]; }
        __syncthreads();
        float totk[4] = {0.f, 0.f, 0.f, 0.f};
#pragma unroll
        for (int m = 0; m < 4; ++m) {
            const f32x4 pa = *(const LAS f32x4*)(lds + A_OFF + ((16 * m + fr) * 32 + 16 * d + 4 * fq) * 4);
            const s16x4 af = __builtin_bit_cast(s16x4, (u32x2){pg8::cvt_pk_bf16(pa[0], pa[1]), pg8::cvt_pk_bf16(pa[2], pa[3])});
#pragma unroll
            for (int kb = 0; kb < 4; ++kb) {
                const f32x4 x = __builtin_amdgcn_mfma_f32_16x16x16bf16_1k(af, bw[kb], (f32x4){bias4[kb], bias4[kb], bias4[kb], bias4[kb]}, 0, 0, 0);
                const int l = 16 * kb + fr, la_o = (l < 32 ? QT_OFF : KT_OFF) + d * 64 * RS + 128 * (wv & 3) + 4 * (l & 31);
#pragma unroll
                for (int i = 0; i < 4; ++i) { const float la = lsig2(x[i]); totk[kb] += la; *(LAS float*)(lds + la_o + (16 * m + 4 * fq + i) * RS) = la; }
            }
        }
#pragma unroll
        for (int kb = 0; kb < 4; ++kb) { totk[kb] += __shfl_xor(totk[kb], 16); totk[kb] += __shfl_xor(totk[kb], 32); }
        const float tot = fq == 0 ? totk[0] : fq == 1 ? totk[1] : fq == 2 ? totk[2] : totk[3];
        const int la_off = ((k & 63) < 32 ? QT_OFF : KT_OFF) + d * 64 * RS + 128 * ((k >> 6) & 3) + 4 * (k & 31);
        float cum = 0.f;
        const bf16_t* qbase = w.P_() + (size_t)r0 * LDP + PQ + h * 256 + k; const bf16_t* kbase = w.P_() + (size_t)r0 * LDP + PK + h * 256 + k;
        auto load_blk = [&](int c, bf16_t (&qv_)[8], bf16_t (&kv_)[8]) {
#pragma unroll
            for (int i = 0; i < 8; ++i) { const int t = d ? 63 - (c * 8 + i) : c * 8 + i; qv_[i] = qbase[(size_t)t * LDP]; kv_[i] = kbase[(size_t)t * LDP]; } };
        auto do_blk = [&](int c, const bf16_t (&qv_)[8], const bf16_t (&kv_)[8]) {
            bf16_t kev[8];
#pragma unroll
            for (int i = 0; i < 8; ++i) {
                const int t = d ? 63 - (c * 8 + i) : c * 8 + i;
                cum += *(const LAS float*)(lds + la_off + t * RS);
                const float q = bf2f(qv_[i]), kk = bf2f(kv_[i]);
                const unsigned qk = pg8::cvt_pk_bf16(q * __builtin_amdgcn_exp2f(cum), kk * __builtin_amdgcn_exp2f(-cum));
                const bf16_t qtv = (bf16_t)(qk & 0xffffu), ktv = (bf16_t)(qk >> 16);
                kev[i] = (bf16_t)(pg8::cvt_pk_bf16(kk * __builtin_amdgcn_exp2f(tot - cum), 0.f) & 0xffffu);
                *(LAS bf16_t*)(lds + QT_OFF + (d * 64 + t) * RS + k * 2) = qtv; *(LAS bf16_t*)(lds + KT_OFF + (d * 64 + t) * RS + k * 2) = ktv;
                asm volatile("" ::: "memory");
            }
            const int t0 = d ? 56 - c * 8 : c * 8;
            uint4 o;
            o.x = d ? ((unsigned)kev[7] | ((unsigned)kev[6] << 16)) : ((unsigned)kev[0] | ((unsigned)kev[1] << 16));
            o.y = d ? ((unsigned)kev[5] | ((unsigned)kev[4] << 16)) : ((unsigned)kev[2] | ((unsigned)kev[3] << 16));
            o.z = d ? ((unsigned)kev[3] | ((unsigned)kev[2] << 16)) : ((unsigned)kev[4] | ((unsigned)kev[5] << 16));
            o.w = d ? ((unsigned)kev[1] | ((unsigned)kev[0] << 16)) : ((unsigned)kev[6] | ((unsigned)kev[7] << 16));
            *(uint4*)(w.ket_() + ((((size_t)d * NCH + cg) * 4 + h) * 256 + k) * 64 + t0) = o;
        };
        { bf16_t qA[8], kA[8], qB[8], kB[8];
          load_blk(0, qA, kA);
#pragma unroll 1
          for (int c = 0; c < 8; c += 2) { load_blk(c + 1, qB, kB); do_blk(c, qA, kA); load_blk(c + 2 < 8 ? c + 2 : 7, qA, kA); do_blk(c + 1, qB, kB); } }
        w.gd_()[((size_t)d * NCH + cg) * 1024 + h * 256 + k] = __builtin_amdgcn_exp2f(tot);
        __syncthreads();
#pragma unroll
        for (int i = 0; i < 8; ++i) { const int idx = tid + i * 512, row = idx >> 5, pc = idx & 31;
            *(u32x4*)(w.qt_() + ((size_t)(row >> 6) * MT + r0 + (row & 63)) * 1024 + h * 256 + pc * 8) = lds_ld16(lds + QT_OFF + row * RS + pc * 16); }
        if (L == 1 && cg >= 128) continue;
        { const int mi = wv & 3;
#pragma unroll
          for (int sb = 0; sb < 2; ++sb) { const int si = 2 * (wv >> 2) + sb;
              f32x4 af = {0.f, 0.f, 0.f, 0.f}, ab = {0.f, 0.f, 0.f, 0.f};
              if (si <= mi) {
#pragma unroll
                  for (int ks = 0; ks < 8; ++ks) af = MFMA16(lds8(lds + KT_OFF + (16 * si + fr) * RS + (32 * ks + 8 * fq) * 2), lds8(lds + QT_OFF + (16 * mi + fr) * RS + (32 * ks + 8 * fq) * 2), af); }
              if (si >= mi) {
#pragma unroll
                  for (int ks = 0; ks < 8; ++ks) ab = MFMA16(lds8(lds + KT_OFF + (64 + 16 * si + fr) * RS + (32 * ks + 8 * fq) * 2), lds8(lds + QT_OFF + (64 + 16 * mi + fr) * RS + (32 * ks + 8 * fq) * 2), ab); }
              float v[4];
#pragma unroll
              for (int r = 0; r < 4; ++r) { const int sl = 16 * si + 4 * fq + r, tl = 16 * mi + fr; v[r] = (sl <= tl ? af[r] : 0.f) + (sl >= tl ? ab[r] : 0.f); }
              asm volatile("s_nop 0" ::: "memory");
              u32x2 pk; pk.x = pg8::cvt_pk_bf16(v[0], v[1]); pk.y = pg8::cvt_pk_bf16(v[2], v[3]);
              lds_st8(lds + A_OFF + (16 * mi + fr) * ARS + (16 * si + 4 * fq) * 2, pk); } }
        __syncthreads();
        constexpr int VP = 1056;
#pragma unroll
        for (int i = 0; i < 8; ++i) { const int idx = tid + i * 512, sr = idx >> 6, pc = idx & 63;
            lds_st16(lds + sr * VP + pc * 16, *(const u32x4*)(w.P_() + (size_t)(r0 + sr) * LDP + PV + h * 512 + pc * 8)); }
        __syncthreads();
        { f32x4 acc[4][4];
#pragma unroll
          for (int nb = 0; nb < 4; ++nb)
#pragma unroll
              for (int mb = 0; mb < 4; ++mb) acc[nb][mb] = (f32x4){0.f, 0.f, 0.f, 0.f};
#pragma unroll
          for (int ks = 0; ks < 2; ++ks) { bf16x8 af[4], vf[4];
#pragma unroll
              for (int mb = 0; mb < 4; ++mb) af[mb] = lds8(lds + A_OFF + (16 * mb + fr) * ARS + (32 * ks + 8 * fq) * 2);
#pragma unroll
              for (int nb = 0; nb < 4; ++nb) vf[nb] = lds_tr8(lds + (32 * ks) * VP + (64 * wv + 16 * nb) * 2, VP, lane);
#pragma unroll
              for (int nb = 0; nb < 4; ++nb)
#pragma unroll
                  for (int mb = 0; mb < 4; ++mb) acc[nb][mb] = MFMA16(vf[nb], af[mb], acc[nb][mb]); }
#pragma unroll
          for (int nb = 0; nb < 4; ++nb)
#pragma unroll
              for (int mb = 0; mb < 4; ++mb) { u32x2 pk; pk.x = pg8::cvt_pk_bf16(acc[nb][mb][0], acc[nb][mb][1]); pk.y = pg8::cvt_pk_bf16(acc[nb][mb][2], acc[nb][mb][3]);
                  *(u32x2*)(w.oi_() + (size_t)(r0 + 16 * mb + fr) * D + h * 512 + 64 * wv + 16 * nb + 4 * fq) = pk; } }
    }
    { unsigned char* lds = ldsb; CONV_SLOT(L == 0 ? 0 : 8, NCH * NH); }
}

DI int st_addr(int n, int kbyte) { return n * 528 + kbyte; }
template <int L> DI void ph_g2_fast(const Params& p, const Ws& w, int bid, int nblk, unsigned char* ldsb) {
    constexpr int VRS = 288, VTB = 64 * VRS, V_OFF = 128 * 528, G_OFF = V_OFF + 2 * VTB;
    LAS unsigned char* lds = (LAS unsigned char*)ldsb;
    const int tid = threadIdx.x, lane = tid & 63, wv = tid >> 6, fr = lane & 15, fq = lane >> 4, mq = wv & 3, nh = wv >> 2;
    const int ng2 = nblk >= 256 ? 128 : nblk;
    if (bid >= ng2) { conv_slot_direct(p, slot_begin(L == 0 ? 1 : 9), slot_begin(L == 0 ? 2 : 10), bid - ng2, nblk - ng2, ldsb); return; }
    for (int u = bid; u < 128; u += ng2) {
        const int xcd = u & 7, idx = u >> 3, chain = xcd * 4 + (idx >> 2), j = idx & 3, d = chain & 1, h = (chain >> 1) & 3, b = chain >> 3;
        auto chunk_of = [&](int step) { return step < 4 ? 128 + b * 4 + (d ? 3 - step : step) : b * 32 + (d ? 31 - (step - 4) : (step - 4)); };
        auto vsrc = [&](int step) { return (const u32x4*)(w.P_() + (size_t)(chunk_of(step) * 64 + (tid >> 3)) * LDP + PV + h * 512 + j * 128 + (tid & 7) * 16); };
        auto vpark = [&](int stage, const u32x4 a0, const u32x4 a1) { LAS unsigned char* q = lds + V_OFF + stage * VTB + (tid >> 3) * VRS + (tid & 7) * 32; lds_st16(q, a0); lds_st16(q + 16, a1); };
        auto gsrc = [&](int step) { return (const u32x4*)(w.gd_() + ((size_t)d * NCH + chunk_of(step)) * 1024 + h * 256 + (tid & 63) * 4); };
        auto gpark = [&](int stage, const u32x4 g4) { if (tid < 64) lds_st16(lds + G_OFF + stage * 1024 + tid * 16, g4); };
        __syncthreads();
        for (int i = tid; i < 128 * 528 / 16; i += 512) lds_st16(lds + i * 16, (u32x4){0u, 0u, 0u, 0u});
        { const u32x4* s0 = vsrc(0); vpark(0, s0[0], s0[1]); gpark(0, *gsrc(0)); }
        __syncthreads();
        f32x4 S[2][8];
#pragma unroll
        for (int kb = 0; kb < 2; ++kb)
#pragma unroll
            for (int nb = 0; nb < 8; ++nb) S[kb][nb] = (f32x4){0.f, 0.f, 0.f, 0.f};
        bf16x8 ke[2][2], qa[8];
        auto load_upd = [&](int step, bf16x8 (&ke_)[2][2]) {
            const int cg = chunk_of(step);
            const bf16_t* kep = w.ket_() + ((((size_t)d * NCH + cg) * 4 + h) * 256 + 32 * wv) * 64;
#pragma unroll
            for (int kb = 0; kb < 2; ++kb)
#pragma unroll
                for (int s2 = 0; s2 < 2; ++s2) ke_[kb][s2] = ldg8(kep + (16 * kb + fr) * 64 + 32 * s2 + 8 * fq);
        };
        auto load_q = [&](int step) {
            const bf16_t* qtp = w.qt_() + ((size_t)d * MT + chunk_of(step) * 64 + 16 * mq + fr) * 1024 + h * 256;
#pragma unroll
            for (int s8 = 0; s8 < 8; ++s8) qa[s8] = ldg8(qtp + 32 * s8 + 8 * fq);
        };
        auto compute_step = [&](int step, const bf16x8 (&ke_)[2][2], const u32x4 vn0, const u32x4 vn1, const u32x4 gn) {
            const int cg = chunk_of(step), cur = step & 1;
            f32x4 gv_[2];
#pragma unroll
            for (int kb = 0; kb < 2; ++kb) gv_[kb] = *(const LAS f32x4*)(lds + G_OFF + cur * 1024 + (32 * wv + 16 * kb + 4 * fq) * 4);
#pragma unroll
            for (int kb = 0; kb < 2; ++kb)
#pragma unroll
                for (int nb = 0; nb < 8; ++nb) S[kb][nb] = S[kb][nb] * gv_[kb];
#pragma unroll
            for (int s2 = 0; s2 < 2; ++s2)
#pragma unroll
                for (int nb = 0; nb < 8; ++nb) { const bf16x8 vf = lds_tr8(lds + V_OFF + cur * VTB + (32 * s2) * VRS + (16 * nb) * 2, VRS, lane);
#pragma unroll
                    for (int kb = 0; kb < 2; ++kb) S[kb][nb] = MFMA16(ke_[kb][s2], vf, S[kb][nb]);
                    if (nb & 1) asm volatile("" ::: "memory"); }
            if (L == 0 || cg < 128)
#pragma unroll
            for (int hb = 0; hb < 2; ++hb) {
                f32x4 O[2] = {(f32x4){0.f, 0.f, 0.f, 0.f}, (f32x4){0.f, 0.f, 0.f, 0.f}};
#pragma unroll
                for (int s8 = 0; s8 < 8; ++s8)
#pragma unroll
                    for (int n2 = 0; n2 < 2; ++n2) O[n2] = MFMA16(lds8(lds + st_addr(64 * nh + 32 * hb + 16 * n2 + fr, (32 * s8 + 8 * fq) * 2)), qa[s8], O[n2]);
#pragma unroll
                for (int n2 = 0; n2 < 2; ++n2) { u32x2 pk; pk.x = pg8::cvt_pk_bf16(O[n2][0], O[n2][1]); pk.y = pg8::cvt_pk_bf16(O[n2][2], O[n2][3]);
                    *(u32x2*)(w.of_() + ((size_t)d * MT + cg * 64 + 16 * mq + fr) * D + h * 512 + j * 128 + 64 * nh + 32 * hb + 16 * n2 + 4 * fq) = pk; }
            }
            load_q(step + 1 < 36 ? step + 1 : 35);
            asm volatile("s_waitcnt lgkmcnt(0)" ::: "memory"); __builtin_amdgcn_s_barrier(); asm volatile("" ::: "memory");
#pragma unroll
            for (int kb = 0; kb < 2; ++kb)
#pragma unroll
                for (int nb = 0; nb < 8; ++nb) { u32x2 pk; pk.x = pg8::cvt_pk_bf16(S[kb][nb][0], S[kb][nb][1]); pk.y = pg8::cvt_pk_bf16(S[kb][nb][2], S[kb][nb][3]);
                    lds_st8(lds + st_addr(16 * nb + fr, (32 * wv + 16 * kb + 4 * fq) * 2), pk); }
            vpark(cur ^ 1, vn0, vn1); gpark(cur ^ 1, gn);
            asm volatile("s_waitcnt lgkmcnt(0)" ::: "memory"); __builtin_amdgcn_s_barrier(); asm volatile("" ::: "memory");
        };
        load_upd(0, ke); load_q(0);
#pragma unroll 1
        for (int step = 0; step < 36; step += 2) {
            bf16x8 keN[2][2];
            { const u32x4* sb = vsrc(step + 1); const u32x4 vb0 = sb[0], vb1 = sb[1], gb = *gsrc(step + 1);
              load_upd(step + 1, keN);
              compute_step(step, ke, vb0, vb1, gb); }
            { const int sn = step + 2 < 36 ? step + 2 : 35; const u32x4* sa = vsrc(sn); const u32x4 va0 = sa[0], va1 = sa[1], ga = *gsrc(sn);
              load_upd(sn, ke);
              compute_step(step + 1, keN, va0, va1, ga); }
        }
    }
}

constexpr int LDS_BYTES = 155648;
constexpr int PH_ADA = 0, PH_MODFIN = 1, PH_T1 = 2, PH_L0 = 3, NPL = 12, NPH = PH_L0 + 2 * NPL;
constexpr int L_INPROJ = 0, L_G1 = 1, L_G2 = 2, L_G3 = 3, L_PA = 4, L_PB = 5, L_WO = 6, L_T2 = 7, L_SCAT = 8, L_F1 = 9, L_F2 = 10, L_T3 = 11;

#ifndef PHSEL
#define PHSEL(k) true
#endif
#ifndef REPEAT
#define REPEAT 0
#endif
constexpr int RB_CONV = 1, RB_INPROJ = 2, RB_G1 = 4, RB_G2 = 8, RB_G3 = 16, RB_PAB = 32, RB_WO = 64, RB_F1 = 128, RB_F2 = 256, RB_ADA = 512, RB_T1 = 1024, RB_SCAT = 2048;
#define REP(bit) for (int rep_ = 0; rep_ < ((REPEAT & (bit)) ? 2 : 1); ++rep_)
#define REP2(bit, call) do { if (REPEAT & (bit)) { call; } call; } while (0)
template <int L> DI void layer_phases(const Params& p, const Ws& w, int bid, int nblk, unsigned char* lds, const XcdBarrier& bar) {
    const int lo = p.ph_lo, hi = p.ph_hi, base = PH_L0 + L * NPL;
#define IN(k) (PHSEL(base + (k)) && lo <= base + (k) && base + (k) < hi)
#define SEAM(k) do { if (lo <= base + (k) && base + (k) + 1 < hi) xcd_barrier(bar); } while (0)
    if (IN(L_INPROJ)) { if (FAST & FB_INPROJ) REP2(RB_INPROJ, ph_inproj_fast<L>(p, w, bid, nblk, lds)); else ph_inproj_naive<L>(p, w, bid, nblk, lds); }
    SEAM(L_INPROJ);
    if (IN(L_G1)) REP(RB_G1) { if (FAST & FB_G1) ph_g1_fast<L>(p, w, bid, nblk, lds); else ph_g1_naive<L>(p, w, bid, nblk, lds); }
    SEAM(L_G1);
    if (IN(L_G2)) REP(RB_G2) { if (FAST & FB_G2) ph_g2_fast<L>(p, w, bid, nblk, lds); else ph_g2_naive<L>(p, w, bid, nblk, lds); }
    if (IN(L_G2) && (!(FAST & FB_G2) || nblk < 256)) conv_slot_direct(p, slot_begin(L == 0 ? 1 : 9), slot_begin(L == 0 ? 2 : 10), bid, nblk, lds);
    SEAM(L_G2);
    if (IN(L_G3)) REP(RB_G3) ph_g3<L>(p, w, bid, nblk);
    SEAM(L_G3);
    if (IN(L_PA)) REP(RB_PAB) { if (FAST & FB_PA) ph_pa_fast<L>(p, w, bid, nblk, lds); else ph_pa_naive<L>(p, w, bid, nblk, lds); }
    if (!((FAST & FB_PA) && (FAST & FB_PB))) SEAM(L_PA);
    if (IN(L_PB)) REP(RB_PAB) { if (FAST & FB_PB) ph_pb_fast<L>(p, w, bid, nblk, lds); else ph_pb_naive<L>(p, w, bid, nblk, lds); }
    SEAM(L_PB);
    if (IN(L_WO)) REP(RB_WO) { if (FAST & FB_WO) ph_wo_fast<L>(p, w, bid, nblk, lds); else ph_wo_naive<L>(p, w, bid, nblk, lds); }
    SEAM(L_WO);
    if (IN(L_T2)) ph_t2<L>(p, w, bid, nblk, lds);
    SEAM(L_T2);
    if (L == 1) { if (IN(L_SCAT)) REP(RB_SCAT) { if (FAST & FB_CONV) conv_stream([&](int i) { return conv_deferred(p, p.ws, i); }, slot_begin(NSLOT), DT_END, bid, nblk, lds);
        ph_scatter(p, w, bid, nblk); } SEAM(L_SCAT); }
    if (IN(L_F1)) { if (FAST & FB_F1) REP2(RB_F1, ph_f1_fast<L>(p, w, bid, nblk, lds)); else ph_f1_naive<L>(p, w, bid, nblk, lds); }
    SEAM(L_F1);
    if (IN(L_F2)) { if (FAST & FB_F2) REP2(RB_F2, ph_f2_fast<L>(p, w, bid, nblk, lds)); else ph_f2_naive<L>(p, w, bid, nblk, lds); }
    SEAM(L_F2);
    if (IN(L_T3)) ph_t3<L>(p, w, bid, nblk);
    if (L == 0) SEAM(L_T3);
#undef SEAM
#undef IN
}

__global__ void __launch_bounds__(512, 2) k_fwd(Params p) {
    extern __shared__ __attribute__((aligned(16))) unsigned char lds[];
    const Ws w = make_ws(p.ws);
    const int bid = blockIdx.x, nblk = gridDim.x;
    volatile LAS unsigned* bst = (volatile LAS unsigned*)(lds + LDS_BYTES - 16);
    if (threadIdx.x == 0) { bst[0] = 0u; bst[1] = 0u; bst[2] = 0u; bst[3] = 0u; }
    __syncthreads();
    XcdBarrier bar; bar.bar = w.ctl_() + CW_BAR; bar.x = 0; bar.st = bst;
    if (p.ph_hi - p.ph_lo > 1) bar = xcd_barrier_post(w.ctl_() + CW_BAR, bst);
    const int lo = p.ph_lo, hi = p.ph_hi;
#define SEAM0(k) do { if (lo <= (k) && (k) + 1 < hi) xcd_barrier(bar); } while (0)
    if (PHSEL(PH_ADA) && lo <= PH_ADA && PH_ADA < hi) { REP(RB_ADA) ph_ada(p, w, bid, nblk, lds); if (FAST & FB_CONV) REP(RB_CONV) ph_convert(p, p.ws, bid, nblk, lds); }
    SEAM0(PH_ADA);
    if (PHSEL(PH_MODFIN) && lo <= PH_MODFIN && PH_MODFIN < hi) ph_modfin(p, w, bid, nblk);
    SEAM0(PH_MODFIN);
    if (PHSEL(PH_T1) && lo <= PH_T1 && PH_T1 < hi) REP(RB_T1) ph_t1(p, w, bid, nblk);
    SEAM0(PH_T1);
#undef SEAM0
    layer_phases<0>(p, w, bid, nblk, lds, bar);
    layer_phases<1>(p, w, bid, nblk, lds, bar);
}

extern "C" void kernel_launch(void* const* d_in, const int* in_sizes, int n_in, void* d_out, int out_size, void* d_ws, size_t ws_size, hipStream_t stream) {
    static int grid = 0;
    if (grid == 0) {
        if (n_in != 28 || ws_size < WS_END2) { fprintf(stderr, "kernel_launch: expected 28 inputs and >= %zu bytes of workspace; got %d, %zu\n", (size_t)WS_END2, n_in, ws_size); grid = -1; return; }
        int dev = 0, cus = 0;
        if (hipGetDevice(&dev) != hipSuccess || hipDeviceGetAttribute(&cus, hipDeviceAttributeMultiprocessorCount, dev) != hipSuccess) { grid = -1; return; }
        if (hipFuncSetAttribute((const void*)k_fwd, hipFuncAttributeMaxDynamicSharedMemorySize, LDS_BYTES) != hipSuccess) { fprintf(stderr, "kernel_launch: hipFuncSetAttribute failed\n"); grid = -1; return; }
        grid = cus > 0 ? cus : 256;
    }
    if (grid < 0) return;
    (void)hipMemsetAsync((char*)d_ws + WS_CTL, 0, CTL_BYTES, stream);
    Params p{};
    const float** pp = (const float**)&p;
    for (int i = 0; i < 28; ++i) pp[i] = (const float*)d_in[i];
    p.out = (float*)d_out; p.ws = (unsigned char*)d_ws;
#ifndef MK_PER_PHASE
    p.ph_lo = 0; p.ph_hi = NPH;
    hipLaunchKernelGGL(k_fwd, dim3(grid), dim3(512), LDS_BYTES, stream, p);
#else
    for (int ph = 0; ph < NPH; ++ph) {
        if (ph == PH_L0 + L_SCAT) continue;
        p.ph_lo = ph; p.ph_hi = ph + 1;
        hipLaunchKernelGGL(k_fwd, dim3(grid), dim3(512), LDS_BYTES, stream, p);
    }
#endif
}
```

```cpp
#include <hip/hip_runtime.h>
#include <cstdio>
#include <cstdint>

#define DI __device__ __forceinline__
typedef unsigned short bf16_t;
typedef float f32x4 __attribute__((ext_vector_type(4)));

constexpr int D = 2048, NBATCH = 4, SEQ = 2048, CTXL = 256;
constexpr int ML = NBATCH * SEQ, MC = NBATCH * CTXL, MT = ML + MC;
constexpr int HK = 256, HV = 512, NH = 4, DFF = 5632, NE = 8;
constexpr int NIN = 16416;
constexpr int OFF_Q = 0, OFF_K = 1024, OFF_V = 2048, OFF_AF = 4096, OFF_R = 4128, OFF_CB = 6176, OFF_CC = 8224, OFF_CX = 10272, OFF_GA = 12320, OFF_GB = 14368;
constexpr int PQ = 0, PK = 1024, PV = 2048, PSR = 4096, PCB = 6144, PU = 8192, PGA = 10240, PGB = 12288, LDP = 14336;
constexpr int NCH = MT / 64;
constexpr int MSORT = 18432;
constexpr float EPS = 1e-6f;

constexpr size_t al256(size_t x) { return (x + 255) & ~(size_t)255; }
constexpr size_t WS_CTL = 0, CTL_BYTES = 1u << 20;
constexpr size_t WS_MODP = WS_CTL + CTL_BYTES;
constexpr size_t WS_MOD = WS_MODP + al256((size_t)8 * 2 * 5 * 12288 * 4);
constexpr size_t WS_XS = WS_MOD + al256((size_t)2 * 5 * 12288 * 4);
constexpr size_t WS_H = WS_XS + (size_t)MT * D * 4;
constexpr size_t WS_PG = WS_H + (size_t)MT * D * 2;
constexpr size_t WS_P = WS_PG + (size_t)MT * 32 * 4;
constexpr size_t WS_GG = WS_P;
constexpr size_t P_BYTES = (size_t)MT * LDP * 2;
static_assert((size_t)MSORT * DFF * 2 <= P_BYTES, "GG overlay");
constexpr size_t WS_GLA = WS_P + P_BYTES;
constexpr size_t WS_QT = WS_GLA;
constexpr size_t WS_KET = WS_QT + (size_t)2 * MT * 1024 * 2;
constexpr size_t WS_VT = WS_KET + (size_t)2 * NCH * 4 * 256 * 64 * 2;
constexpr size_t WS_OI = WS_VT + (size_t)NCH * 4 * 512 * 64 * 2;
constexpr size_t WS_OF = WS_OI + (size_t)MT * D * 2;
constexpr size_t WS_GD = WS_OF + (size_t)2 * MT * D * 2;
constexpr size_t GLA_END = WS_GD + (size_t)2 * NCH * 1024 * 4;
constexpr size_t WS_HS = WS_GLA;
constexpr size_t WS_YS = WS_HS + (size_t)MSORT * D * 2;
constexpr size_t MOE_END = WS_YS + (size_t)MSORT * D * 4;
constexpr size_t WS_OBR = (GLA_END > MOE_END ? GLA_END : MOE_END);
constexpr size_t WS_YA = WS_OBR + (size_t)MT * D * 2;
constexpr size_t WS_MA = WS_YA + (size_t)MT * D * 2;
constexpr size_t WS_MRG = WS_MA + (size_t)MT * D * 4;
constexpr size_t WS_MM = WS_MRG + (size_t)MT * D * 2;
constexpr size_t WS_TOK = WS_MM + (size_t)MT * D * 4;
constexpr size_t WS_END = WS_TOK + (size_t)ML * 2 * 4 * 3;
constexpr int CW_BAR = 0;
constexpr int CW_CNT = 8192;
#ifndef FAST
#define FAST 0xFFFF
#endif
constexpr int FB_CONV = 1, FB_INPROJ = 2, FB_PA = 4, FB_PB = 8, FB_WO = 16, FB_F1 = 32, FB_F2 = 64, FB_G1 = 128, FB_G2 = 256;
constexpr size_t WS_WIN = WS_END;
constexpr size_t WS_WG = WS_WIN + (size_t)2 * 16384 * 2048 * 2;
constexpr size_t WS_WA = WS_WG + (size_t)2 * 64 * 2048 * 2;
constexpr size_t WS_WB = WS_WA + (size_t)2 * 2048 * 2048 * 2;
constexpr size_t WS_WO = WS_WB + (size_t)2 * 2048 * 2048 * 2;
constexpr size_t WS_F1 = WS_WO + (size_t)2 * 2048 * 2048 * 2;
constexpr size_t WS_F2 = WS_F1 + (size_t)11264 * 2048 * 2;
constexpr size_t WS_M1 = WS_F2 + (size_t)2048 * 5632 * 2;
constexpr size_t WS_M2 = WS_M1 + (size_t)8 * 11264 * 2048 * 2;
constexpr size_t WS_MMP = WS_M2 + (size_t)8 * 2048 * 5632 * 2;
constexpr size_t WS_YSP = WS_MMP + (size_t)4 * MC * D * 4;
constexpr size_t WS_END2 = WS_YSP + (size_t)4 * 2048 * D * 4;

struct Params {
    const float *x, *c, *ctx, *c_ctx, *w_ada, *b_ada, *pre_mix_g, *post_mix_g, *pre_ffn_g, *post_ffn_g, *w_in, *gate_w2_f, *gate_b_f, *gate_w2_b, *gate_b_b,
        *gla_norm_g, *conv_w, *conv_b, *w_proj_a, *w_proj_b, *w_out, *ffn_w1, *ffn_w3, *ffn_w2, *router_w, *moe_w1, *moe_w3, *moe_w2;
    float* out; unsigned char* ws; int ph_lo, ph_hi;
};

DI float bf2f(bf16_t v) { return __uint_as_float((unsigned)v << 16); }
DI bf16_t f2bf(float f) { unsigned u = __float_as_uint(f); u += 0x7FFFu + ((u >> 16) & 1u); return (bf16_t)(u >> 16); }
DI unsigned pack2(float lo, float hi) { return (unsigned)f2bf(lo) | ((unsigned)f2bf(hi) << 16); }
DI float siluf(float v) { return v / (1.f + __expf(-v)); }
DI float sigmf(float v) { return 1.f / (1.f + __expf(-v)); }
DI float wave_sum(float s) {
#pragma unroll
    for (int o = 32; o >= 1; o >>= 1) s += __shfl_xor(s, o);
    return s;
}
DI void ld_row_f32(const float* p, int lane, float (&v)[4][8]) {
#pragma unroll
    for (int j = 0; j < 4; ++j) { const float4* q = (const float4*)(p + (j * 64 + lane) * 8); const float4 a = q[0], b = q[1];
        v[j][0] = a.x; v[j][1] = a.y; v[j][2] = a.z; v[j][3] = a.w; v[j][4] = b.x; v[j][5] = b.y; v[j][6] = b.z; v[j][7] = b.w; }
}
typedef float f32x4n __attribute__((ext_vector_type(4)));
typedef unsigned u32x4n __attribute__((ext_vector_type(4)));
DI void ld_row_f32_nt(const float* p, int lane, float (&v)[4][8]) {
#pragma unroll
    for (int j = 0; j < 4; ++j) { const f32x4n* q = (const f32x4n*)(p + (j * 64 + lane) * 8); const f32x4n a = __builtin_nontemporal_load(q), b = __builtin_nontemporal_load(q + 1);
        v[j][0] = a[0]; v[j][1] = a[1]; v[j][2] = a[2]; v[j][3] = a[3]; v[j][4] = b[0]; v[j][5] = b[1]; v[j][6] = b[2]; v[j][7] = b[3]; }
}
DI void ld_row_bf16_nt(const bf16_t* p, int lane, float (&v)[4][8]) {
#pragma unroll
    for (int j = 0; j < 4; ++j) { const u32x4n w = __builtin_nontemporal_load((const u32x4n*)(p + (j * 64 + lane) * 8));
        v[j][0] = __uint_as_float(w[0] << 16); v[j][1] = __uint_as_float(w[0] & 0xffff0000u); v[j][2] = __uint_as_float(w[1] << 16); v[j][3] = __uint_as_float(w[1] & 0xffff0000u);
        v[j][4] = __uint_as_float(w[2] << 16); v[j][5] = __uint_as_float(w[2] & 0xffff0000u); v[j][6] = __uint_as_float(w[3] << 16); v[j][7] = __uint_as_float(w[3] & 0xffff0000u); }
}
DI void ld8_bf16_nt(const bf16_t* p, float (&v)[8]) { const u32x4n w = __builtin_nontemporal_load((const u32x4n*)p);
    v[0] = __uint_as_float(w[0] << 16); v[1] = __uint_as_float(w[0] & 0xffff0000u); v[2] = __uint_as_float(w[1] << 16); v[3] = __uint_as_float(w[1] & 0xffff0000u);
    v[4] = __uint_as_float(w[2] << 16); v[5] = __uint_as_float(w[2] & 0xffff0000u); v[6] = __uint_as_float(w[3] << 16); v[7] = __uint_as_float(w[3] & 0xffff0000u); }
DI void ld_row_part4(const float* p, size_t stride, int lane, float (&v)[4][8]) {
    float t[4][8]; ld_row_f32(p, lane, v);
#pragma unroll
    for (int s = 1; s < 4; ++s) { ld_row_f32(p + s * stride, lane, t);
#pragma unroll
        for (int j = 0; j < 4; ++j)
#pragma unroll
            for (int i = 0; i < 8; ++i) v[j][i] += t[j][i]; }
}
DI void ld_row_bf16(const bf16_t* p, int lane, float (&v)[4][8]) {
#pragma unroll
    for (int j = 0; j < 4; ++j) { const uint4 w = *(const uint4*)(p + (j * 64 + lane) * 8);
        v[j][0] = __uint_as_float(w.x << 16); v[j][1] = __uint_as_float(w.x & 0xffff0000u); v[j][2] = __uint_as_float(w.y << 16); v[j][3] = __uint_as_float(w.y & 0xffff0000u);
        v[j][4] = __uint_as_float(w.z << 16); v[j][5] = __uint_as_float(w.z & 0xffff0000u); v[j][6] = __uint_as_float(w.w << 16); v[j][7] = __uint_as_float(w.w & 0xffff0000u); }
}
DI void ld8_f32(const float* p, float (&v)[8]) { const float4* q = (const float4*)p; const float4 a = q[0], b = q[1]; v[0] = a.x; v[1] = a.y; v[2] = a.z; v[3] = a.w; v[4] = b.x; v[5] = b.y; v[6] = b.z; v[7] = b.w; }
DI void ld8_bf16(const bf16_t* p, float (&v)[8]) { const uint4 w = *(const uint4*)p;
    v[0] = __uint_as_float(w.x << 16); v[1] = __uint_as_float(w.x & 0xffff0000u); v[2] = __uint_as_float(w.y << 16); v[3] = __uint_as_float(w.y & 0xffff0000u);
    v[4] = __uint_as_float(w.z << 16); v[5] = __uint_as_float(w.z & 0xffff0000u); v[6] = __uint_as_float(w.w << 16); v[7] = __uint_as_float(w.w & 0xffff0000u); }
DI void st_row_f32(float* p, int lane, const float (&v)[4][8]) {
#pragma unroll
    for (int j = 0; j < 4; ++j) { float4* q = (float4*)(p + (j * 64 + lane) * 8); q[0] = make_float4(v[j][0], v[j][1], v[j][2], v[j][3]); q[1] = make_float4(v[j][4], v[j][5], v[j][6], v[j][7]); }
}
DI void st_row_bf16(bf16_t* p, int lane, const float (&v)[4][8]) {
#pragma unroll
    for (int j = 0; j < 4; ++j) { uint4 w; w.x = pack2(v[j][0], v[j][1]); w.y = pack2(v[j][2], v[j][3]); w.z = pack2(v[j][4], v[j][5]); w.w = pack2(v[j][6], v[j][7]); *(uint4*)(p + (j * 64 + lane) * 8) = w; }
}
DI float sumsq(const float (&v)[4][8]) { float s = 0.f;
#pragma unroll
    for (int j = 0; j < 4; ++j)
#pragma unroll
        for (int i = 0; i < 8; ++i) s += v[j][i] * v[j][i];
    return s; }

struct WsV {
    unsigned char* b;
    DI unsigned* ctl_() const { return (unsigned*)(b + WS_CTL); }
    DI float* modp_() const { return (float*)(b + WS_MODP); }
    DI float* mod_() const { return (float*)(b + WS_MOD); }
    DI bf16_t* xs_() const { return (bf16_t*)(b + WS_XS); }
    DI bf16_t* h_() const { return (bf16_t*)(b + WS_H); }
    DI float* pg_() const { return (float*)(b + WS_PG); }
    DI bf16_t* P_() const { return (bf16_t*)(b + WS_P); }
    DI bf16_t* gg_() const { return (bf16_t*)(b + WS_GG); }
    DI bf16_t* qt_() const { return (bf16_t*)(b + WS_QT); }
    DI bf16_t* ket_() const { return (bf16_t*)(b + WS_KET); }
    DI bf16_t* vt_() const { return (bf16_t*)(b + WS_VT); }
    DI bf16_t* oi_() const { return (bf16_t*)(b + WS_OI); }
    DI bf16_t* of_() const { return (bf16_t*)(b + WS_OF); }
    DI float* gd_() const { return (float*)(b + WS_GD); }
    DI bf16_t* hs_() const { return (bf16_t*)(b + WS_HS); }
    DI bf16_t* ys_() const { return (bf16_t*)(b + WS_YS); }
    DI bf16_t* obr_() const { return (bf16_t*)(b + WS_OBR); }
    DI bf16_t* ya_() const { return (bf16_t*)(b + WS_YA); }
    DI bf16_t* ma_() const { return (bf16_t*)(b + WS_MA); }
    DI bf16_t* mrg_() const { return (bf16_t*)(b + WS_MRG); }
    DI bf16_t* mm_() const { return (bf16_t*)(b + WS_MM); }
    DI int* toke_() const { return (int*)(b + WS_TOK); }
    DI int* tokp_() const { return (int*)(b + WS_TOK) + ML * 2; }
    DI float* tokw_() const { return (float*)(b + WS_TOK) + ML * 4; }
};
typedef WsV Ws;
DI Ws make_ws(unsigned char* w) { Ws s; s.b = w; return s; }
DI const float* mod_ptr(const Ws& w, int l, int row, int which) { const int mr = row < ML ? row / SEQ : 4; return w.mod_() + ((size_t)(l * 5 + mr) * 6 + which) * D; }

DI void ph_ada(const Params& p, const Ws& w, int bid, int nblk, unsigned char* ldsb) {
    float* sl = (float*)ldsb;
    const int tid = threadIdx.x, c4 = (tid & 63) * 4, kg = tid >> 6;
    for (int u = bid; u < 2 * 48 * 8; u += nblk) {
        const int ks = u & 7, cb = (u >> 3) % 48, l = u / (8 * 48);
        __syncthreads();
        for (int i = tid; i < 5 * 256; i += 512) { const int r = i >> 8, k = ks * 256 + (i & 255); const float v = r < 4 ? p.c[r * D + k] : p.c_ctx[k]; sl[i] = siluf(v); }
        __syncthreads();
        float acc[5][4];
#pragma unroll
        for (int r = 0; r < 5; ++r)
#pragma unroll
            for (int j = 0; j < 4; ++j) acc[r][j] = 0.f;
        const float* wp = p.w_ada + ((size_t)l * D + ks * 256 + kg * 32) * 12288 + cb * 256 + c4;
#pragma unroll 8
        for (int k = 0; k < 32; ++k) { const f32x4 wv = __builtin_nontemporal_load((const f32x4*)(wp + (size_t)k * 12288));
#pragma unroll
            for (int r = 0; r < 5; ++r) { const float sv = sl[r * 256 + kg * 32 + k];
#pragma unroll
                for (int j = 0; j < 4; ++j) acc[r][j] += sv * wv[j]; } }
        __syncthreads();
        float* red = sl + 5 * 256;
#pragma unroll
        for (int r = 0; r < 5; ++r) *(f32x4*)(red + (kg * 5 + r) * 256 + c4) = (f32x4){acc[r][0], acc[r][1], acc[r][2], acc[r][3]};
        __syncthreads();
        for (int i = tid; i < 5 * 256; i += 512) { const int r = i >> 8, c = i & 255; float sum = 0.f;
#pragma unroll
            for (int g = 0; g < 8; ++g) sum += red[(g * 5 + r) * 256 + c];
            w.modp_()[((size_t)(ks * 2 + l) * 5 + r) * 12288 + cb * 256 + c] = sum; }
    }
}
DI void ph_modfin(const Params& p, const Ws& w, int bid, int nblk) {
    for (int i = bid * 512 + threadIdx.x; i < 2 * 5 * 12288; i += nblk * 512) {
        const int col = i % 12288, l = i / (5 * 12288); float s = p.b_ada[l * 12288 + col];
#pragma unroll
        for (int ks = 0; ks < 8; ++ks) s += w.modp_()[(size_t)ks * 2 * 5 * 12288 + i];
        w.mod_()[i] = s;
    }
}

DI const float* xin_row(const Params& p, int r) { return r < ML ? p.x + (size_t)r * D : p.ctx + (size_t)(r - ML) * D; }
DI void norm_mod_store(const float (&v)[4][8], const float* g, const float* sh, const float* sc, bf16_t* dst, int lane, float (&hout)[4][8]) {
    const float rs = rsqrtf(wave_sum(sumsq(v)) * (1.f / D) + EPS);
    float gv[4][8], a[4][8], b[4][8]; ld_row_f32(g, lane, gv); ld_row_f32(sh, lane, a); ld_row_f32(sc, lane, b);
#pragma unroll
    for (int j = 0; j < 4; ++j)
#pragma unroll
        for (int i = 0; i < 8; ++i) hout[j][i] = v[j][i] * rs * gv[j][i] * (1.f + b[j][i]) + a[j][i];
    st_row_bf16(dst, lane, hout);
}
DI void ph_t1(const Params& p, const Ws& w, int bid, int nblk) {
    const int lane = threadIdx.x & 63, gw = bid * 8 + (threadIdx.x >> 6), nw = nblk * 8;
    for (int r = gw; r < MT; r += nw) {
        float v[4][8], h[4][8]; ld_row_f32_nt(xin_row(p, r), lane, v);
        norm_mod_store(v, p.pre_mix_g, mod_ptr(w, 0, r, 0), mod_ptr(w, 0, r, 1), w.h_() + (size_t)r * D, lane, h);
    }
}
template <int L> DI void ph_t2(const Params& p, const Ws& w, int bid, int nblk, unsigned char* ldsb) {
    constexpr int MR = L == 0 ? MT : ML;
    const int lane = threadIdx.x & 63, gw = bid * 8 + (threadIdx.x >> 6), nw = nblk * 8;
    float* rw_s = (float*)ldsb;
    if (L == 1) { __syncthreads();
        for (int e = threadIdx.x; e < 2048; e += 512) { const float4 a = ((const float4*)p.router_w)[e * 2], b = ((const float4*)p.router_w)[e * 2 + 1];
            rw_s[e] = a.x; rw_s[2048 + e] = a.y; rw_s[4096 + e] = a.z; rw_s[6144 + e] = a.w; rw_s[8192 + e] = b.x; rw_s[10240 + e] = b.y; rw_s[12288 + e] = b.z; rw_s[14336 + e] = b.w; }
        __syncthreads(); }
    for (int r = gw; r < MR; r += nw) {
        float xr[4][8], m[4][8], gv[4][8], g1[4][8], h[4][8];
        if (L == 0) ld_row_f32_nt(xin_row(p, r), lane, xr); else ld_row_bf16_nt(w.xs_() + (size_t)r * D, lane, xr);
        if (L == 0 && (FAST & FB_WO) && r >= ML) ld_row_part4((const float*)(w.b + WS_MMP) + (size_t)(r - ML) * D, (size_t)MC * D, lane, m);
        else ld_row_bf16_nt(w.mm_() + (size_t)r * D, lane, m);
        const float rs = rsqrtf(wave_sum(sumsq(m)) * (1.f / D) + EPS);
        ld_row_f32(p.post_mix_g + L * D, lane, gv); ld_row_f32(mod_ptr(w, L, r, 2), lane, g1);
#pragma unroll
        for (int j = 0; j < 4; ++j)
#pragma unroll
            for (int i = 0; i < 8; ++i) xr[j][i] += g1[j][i] * (m[j][i] * rs * gv[j][i]);
        st_row_bf16(w.xs_() + (size_t)r * D, lane, xr);
        norm_mod_store(xr, p.pre_ffn_g + L * D, mod_ptr(w, L, r, 3), mod_ptr(w, L, r, 4), w.h_() + (size_t)r * D, lane, h);
        if (L == 1) {
            float lg[8] = {0.f, 0.f, 0.f, 0.f, 0.f, 0.f, 0.f, 0.f};
#pragma unroll
            for (int j = 0; j < 4; ++j) {
#pragma unroll
                for (int ex = 0; ex < 8; ++ex) { const float4* rw = (const float4*)(rw_s + ex * 2048 + (j * 64 + lane) * 8); const float4 a = rw[0], b = rw[1];
                    lg[ex] += h[j][0] * a.x + h[j][1] * a.y + h[j][2] * a.z + h[j][3] * a.w + h[j][4] * b.x + h[j][5] * b.y + h[j][6] * b.z + h[j][7] * b.w;
                    if (ex & 1) asm volatile("" ::: "memory"); } }
#pragma unroll
            for (int e = 0; e < 8; ++e) lg[e] = wave_sum(lg[e]);
            if (lane == 0) {
                int e0 = 0; float v0 = lg[0];
#pragma unroll
                for (int e = 1; e < 8; ++e) if (lg[e] > v0) { v0 = lg[e]; e0 = e; }
                int e1 = -1; float v1 = -3.0e38f;
#pragma unroll
                for (int e = 0; e < 8; ++e) if (e != e0 && lg[e] > v1) { v1 = lg[e]; e1 = e; }
                const float p1 = 1.f / (1.f + __expf(v0 - v1)), p0 = 1.f - p1;
                const int q0 = (int)atomicAdd(w.ctl_() + CW_CNT + e0, 1u), q1 = (int)atomicAdd(w.ctl_() + CW_CNT + e1, 1u);
                w.toke_()[r * 2] = e0; w.toke_()[r * 2 + 1] = e1; w.tokp_()[r * 2] = q0; w.tokp_()[r * 2 + 1] = q1; w.tokw_()[r * 2] = p0; w.tokw_()[r * 2 + 1] = p1;
            }
        }
    }
}
DI void moe_offsets(const Ws& w, int (&off)[9]) { int o = 0;
#pragma unroll
    for (int e = 0; e < 8; ++e) { off[e] = o; const int c = (int)__hip_atomic_load(w.ctl_() + CW_CNT + e, __ATOMIC_RELAXED, __HIP_MEMORY_SCOPE_AGENT); o += (c + 255) & ~255; }
    off[8] = o; }
DI void ph_scatter(const Params& p, const Ws& w, int bid, int nblk) {
    int off[9]; moe_offsets(w, off);
    const int lane = threadIdx.x & 63, gw = bid * 8 + (threadIdx.x >> 6), nw = nblk * 8;
    for (int r = gw; r < ML; r += nw) {
        const uint4* __restrict__ src = (const uint4*)(w.h_() + (size_t)r * D);
        const uint4 v0 = src[lane], v1 = src[64 + lane], v2 = src[128 + lane], v3 = src[192 + lane];
        const int e0 = w.toke_()[r * 2], e1 = w.toke_()[r * 2 + 1], q0 = w.tokp_()[r * 2], q1 = w.tokp_()[r * 2 + 1];
        int o0 = 0, o1 = 0;
#pragma unroll
        for (int q = 0; q < 8; ++q) { o0 = (q == e0) ? off[q] : o0; o1 = (q == e1) ? off[q] : o1; }
        uint4* __restrict__ d0 = (uint4*)(w.hs_() + (size_t)(o0 + q0) * D); uint4* __restrict__ d1 = (uint4*)(w.hs_() + (size_t)(o1 + q1) * D);
        d0[lane] = v0; d0[64 + lane] = v1; d0[128 + lane] = v2; d0[192 + lane] = v3;
        d1[lane] = v0; d1[64 + lane] = v1; d1[128 + lane] = v2; d1[192 + lane] = v3;
    }
    for (int e = 0; e < 8; ++e) { const int c = (int)__hip_atomic_load(w.ctl_() + CW_CNT + e, __ATOMIC_RELAXED, __HIP_MEMORY_SCOPE_AGENT); const int lo = off[e] + c, hi = off[e + 1];
        for (int r = lo + gw; r < hi; r += nw) { uint4* dst = (uint4*)(w.hs_() + (size_t)r * D);
#pragma unroll
            for (int j = 0; j < 4; ++j) dst[j * 64 + lane] = make_uint4(0u, 0u, 0u, 0u); } }
}
template <int L> DI void ph_t3(const Params& p, const Ws& w, int bid, int nblk) {
    constexpr int MR = L == 0 ? MT : ML;
    int off[9]; if (L == 1) moe_offsets(w, off);
    const int lane = threadIdx.x & 63, gw = bid * 8 + (threadIdx.x >> 6), nw = nblk * 8;
    for (int r = gw; r < MR; r += nw) {
        float xr[4][8], f[4][8], gv[4][8], g2[4][8];
        ld_row_bf16_nt(w.xs_() + (size_t)r * D, lane, xr);
        if (L == 0) { if ((FAST & FB_F2) && r >= ML) ld_row_part4((const float*)(w.b + WS_MMP) + (size_t)(r - ML) * D, (size_t)MC * D, lane, f); else ld_row_bf16_nt(w.mm_() + (size_t)r * D, lane, f); }
        else {
            float y0[4][8], y1[4][8]; int o0 = 0, o1 = 0; const int e0 = w.toke_()[r * 2], e1 = w.toke_()[r * 2 + 1];
#pragma unroll
            for (int q = 0; q < 8; ++q) { o0 = (q == e0) ? off[q] : o0; o1 = (q == e1) ? off[q] : o1; }
            const int q0 = o0 + w.tokp_()[r * 2], q1 = o1 + w.tokp_()[r * 2 + 1];
            if ((FAST & FB_F2) && q0 >= 16384) ld_row_part4((const float*)(w.b + WS_YSP) + (size_t)(q0 - 16384) * D, (size_t)2048 * D, lane, y0); else ld_row_bf16_nt(w.ys_() + (size_t)q0 * D, lane, y0);
            if ((FAST & FB_F2) && q1 >= 16384) ld_row_part4((const float*)(w.b + WS_YSP) + (size_t)(q1 - 16384) * D, (size_t)2048 * D, lane, y1); else ld_row_bf16_nt(w.ys_() + (size_t)q1 * D, lane, y1);
            const float w0 = w.tokw_()[r * 2], w1 = w.tokw_()[r * 2 + 1];
#pragma unroll
            for (int j = 0; j < 4; ++j)
#pragma unroll
                for (int i = 0; i < 8; ++i) f[j][i] = w0 * y0[j][i] + w1 * y1[j][i];
        }
        const float rs = rsqrtf(wave_sum(sumsq(f)) * (1.f / D) + EPS);
        ld_row_f32(p.post_ffn_g + L * D, lane, gv); ld_row_f32(mod_ptr(w, L, r, 5), lane, g2);
#pragma unroll
        for (int j = 0; j < 4; ++j)
#pragma unroll
            for (int i = 0; i < 8; ++i) xr[j][i] += g2[j][i] * (f[j][i] * rs * gv[j][i]);
        if (L == 0) { st_row_bf16(w.xs_() + (size_t)r * D, lane, xr); float h[4][8];
            norm_mod_store(xr, p.pre_mix_g + D, mod_ptr(w, 1, r, 0), mod_ptr(w, 1, r, 1), w.h_() + (size_t)r * D, lane, h); }
        else st_row_f32(p.out + (size_t)r * D, lane, xr);
    }
}
template <int L> DI void ph_g3(const Params& p, const Ws& w, int bid, int nblk) {
    constexpr int MR = L == 0 ? MT : ML, RB = 4;
    const int lane = threadIdx.x & 63, gw = bid * 8 + (threadIdx.x >> 6), nw = nblk * 8;
#pragma unroll 1
    for (int rb = gw; rb < MR / RB; rb += nw) {
        const int r0 = rb * RB;
        const int pos0 = r0 < ML ? (r0 & 63) : ((r0 - ML) & 255), last = r0 < ML ? 63 : 255;
#pragma unroll
        for (int j = 0; j < 4; ++j) {
            const int e0 = (j * 64 + lane) * 8;
            float ng[8], cw0[8], cw1[8], cw2[8], cbv[8], ul[8], uc[8];
            ld8_f32(p.gla_norm_g + L * D + e0, ng);
            ld8_f32(p.conv_w + (size_t)L * 3 * D + e0, cw0); ld8_f32(p.conv_w + (size_t)L * 3 * D + D + e0, cw1); ld8_f32(p.conv_w + (size_t)L * 3 * D + 2 * D + e0, cw2);
            ld8_f32(p.conv_b + L * D + e0, cbv);
            if (pos0 != 0) ld8_bf16(w.P_() + (size_t)(r0 - 1) * LDP + PU + e0, ul); else {
#pragma unroll
                for (int i = 0; i < 8; ++i) ul[i] = 0.f; }
            ld8_bf16(w.P_() + (size_t)r0 * LDP + PU + e0, uc);
#pragma unroll
            for (int q = 0; q < RB; ++q) {
                const int r = r0 + q;
                float o[8], t[8], ur[8], cbg[8], y[8];
                if (pos0 + q != last) ld8_bf16(w.P_() + (size_t)(r + 1) * LDP + PU + e0, ur); else {
#pragma unroll
                    for (int i = 0; i < 8; ++i) ur[i] = 0.f; }
                ld8_bf16(w.oi_() + (size_t)r * D + e0, o); ld8_bf16(w.of_() + (size_t)r * D + e0, t);
#pragma unroll
                for (int i = 0; i < 8; ++i) o[i] += t[i];
                ld8_bf16(w.of_() + (size_t)(MT + r) * D + e0, t);
                float s = 0.f;
#pragma unroll
                for (int i = 0; i < 8; ++i) { o[i] += t[i]; s += o[i] * o[i]; }
                const float rs = rsqrtf(wave_sum(s) * (1.f / HV) + EPS);
                ld8_bf16(w.P_() + (size_t)r * LDP + PSR + e0, t);
                uint4 ov;
                ov.x = pack2(o[0] * rs * ng[0] * t[0], o[1] * rs * ng[1] * t[1]); ov.y = pack2(o[2] * rs * ng[2] * t[2], o[3] * rs * ng[3] * t[3]);
                ov.z = pack2(o[4] * rs * ng[4] * t[4], o[5] * rs * ng[5] * t[5]); ov.w = pack2(o[6] * rs * ng[6] * t[6], o[7] * rs * ng[7] * t[7]);
                *(uint4*)(w.obr_() + (size_t)r * D + e0) = ov;
                ld8_bf16(w.P_() + (size_t)r * LDP + PCB + e0, cbg);
#pragma unroll
                for (int i = 0; i < 8; ++i) y[i] = cbg[i] * (cbv[i] + cw0[i] * ul[i] + cw1[i] * uc[i] + cw2[i] * ur[i]);
                uint4 yv; yv.x = pack2(y[0], y[1]); yv.y = pack2(y[2], y[3]); yv.z = pack2(y[4], y[5]); yv.w = pack2(y[6], y[7]);
                *(uint4*)(w.ya_() + (size_t)r * D + e0) = yv;
#pragma unroll
                for (int i = 0; i < 8; ++i) { ul[i] = uc[i]; uc[i] = ur[i]; }
            }
            asm volatile("" ::: "memory");
        }
    }
}

struct WSrc { const float* w0; const float* w1; int ld; };
template <int NSRC, class WSel, class Epi>
DI void naive_gemm(const bf16_t* __restrict__ A, int lda, int M, int N, int K, WSel wsel, Epi epi, unsigned char* ldsb, int bid, int nblk) {
    float* As = (float*)ldsb; float* Wl = As + 16 * 68;
    const int tid = threadIdx.x, ty = tid >> 4, tx = tid & 15;
    const int ntm = M / 64, ntn = N / 64;
    for (int tile = bid; tile < ntm * ntn; tile += nblk) {
        const int tm = tile / ntn, tn = tile % ntn, m0 = tm * 64, n0 = tn * 64;
        const WSrc wsrc = wsel(m0, n0);
        float acc[NSRC][2][4];
#pragma unroll
        for (int s = 0; s < NSRC; ++s)
#pragma unroll
            for (int i = 0; i < 2; ++i)
#pragma unroll
                for (int j = 0; j < 4; ++j) acc[s][i][j] = 0.f;
        for (int k0 = 0; k0 < K; k0 += 16) {
            { const unsigned v = *(const unsigned*)(A + (size_t)(m0 + (tid >> 3)) * lda + k0 + (tid & 7) * 2);
              As[((tid & 7) * 2) * 68 + (tid >> 3)] = __uint_as_float(v << 16); As[((tid & 7) * 2 + 1) * 68 + (tid >> 3)] = __uint_as_float(v & 0xffff0000u); }
#pragma unroll
            for (int s = 0; s < NSRC; ++s) { const float2 wv = *(const float2*)((s == 0 ? wsrc.w0 : wsrc.w1) + (size_t)(k0 + (tid >> 5)) * wsrc.ld + (tid & 31) * 2);
                Wl[s * 16 * 68 + (tid >> 5) * 68 + (tid & 31) * 2] = wv.x; Wl[s * 16 * 68 + (tid >> 5) * 68 + (tid & 31) * 2 + 1] = wv.y; }
            __syncthreads();
#pragma unroll
            for (int kk = 0; kk < 16; ++kk) { const float a0 = As[kk * 68 + ty * 2], a1 = As[kk * 68 + ty * 2 + 1];
#pragma unroll
                for (int s = 0; s < NSRC; ++s) { const float4 wv = *(const float4*)(Wl + s * 16 * 68 + kk * 68 + tx * 4);
                    acc[s][0][0] += a0 * wv.x; acc[s][0][1] += a0 * wv.y; acc[s][0][2] += a0 * wv.z; acc[s][0][3] += a0 * wv.w;
                    acc[s][1][0] += a1 * wv.x; acc[s][1][1] += a1 * wv.y; acc[s][1][2] += a1 * wv.z; acc[s][1][3] += a1 * wv.w; } }
            __syncthreads();
        }
#pragma unroll
        for (int i = 0; i < 2; ++i)
#pragma unroll
            for (int j = 0; j < 4; ++j) epi(m0 + ty * 2 + i, n0 + tx * 4 + j, acc[0][i][j], acc[NSRC - 1][i][j]);
    }
}

template <int L> DI void ph_inproj_naive(const Params& p, const Ws& w, int bid, int nblk, unsigned char* lds) {
    const float* win = p.w_in + (size_t)L * D * NIN;
    auto epi = [&](int m, int n, float a0, float a1) {
        bf16_t* P = w.P_() + (size_t)m * LDP;
        if (n < PK) P[n] = f2bf(a0 * 0.0625f);
        else if (n < PSR) P[n] = f2bf(a0);
        else if (n < PCB) P[n] = f2bf(siluf(a0));
        else if (n < PU) P[n] = f2bf(a0);
        else if (n < PGA) P[n] = f2bf(a0 * a1);
        else if (n < LDP) P[n] = f2bf(sigmf(a0));
        else if (n < LDP + 32) w.pg_()[(size_t)m * 32 + (n - LDP)] = a0;
    };
    auto src1 = [&](int n) { return n < PSR ? n   : n < PCB ? OFF_R + (n - PSR) : n < PU ? OFF_CB + (n - PCB) : n < PGB ? OFF_GA + (n - PGA) : n < LDP ? OFF_GB + (n - PGB) : OFF_AF + (n - LDP); };
    naive_gemm<1>(w.h_(), D, MT, PU, D, [&](int, int n0) { return WSrc{win + src1(n0), nullptr, NIN}; }, epi, lds, bid, nblk);
    naive_gemm<1>(w.h_(), D, MT, LDP + 64 - PGA, D, [&](int, int n0) { return WSrc{win + src1(n0 + PGA), nullptr, NIN}; },
                  [&](int m, int n, float a0, float a1) { epi(m, n + PGA, a0, a1); }, lds, bid, nblk);
    naive_gemm<2>(w.h_(), D, MT, 2048, D, [&](int, int n0) { return WSrc{win + OFF_CC + n0, win + OFF_CX + n0, NIN}; },
                  [&](int m, int n, float a0, float a1) { epi(m, n + PU, a0, a1); }, lds, bid, nblk);
}
template <int L> DI void ph_pa_naive(const Params& p, const Ws& w, int bid, int nblk, unsigned char* lds) {
    constexpr int MR = L == 0 ? MT : ML; const float* W0 = p.w_proj_a + (size_t)L * D * D;
    naive_gemm<1>(w.ya_(), D, MR, D, D, [&](int, int n0) { return WSrc{W0 + n0, nullptr, D}; },
                  [&](int m, int n, float a0, float) { w.ma_()[(size_t)m * D + n] = f2bf(a0 * bf2f(w.P_()[(size_t)m * LDP + PGA + n])); }, lds, bid, nblk);
}
template <int L> DI void ph_pb_naive(const Params& p, const Ws& w, int bid, int nblk, unsigned char* lds) {
    constexpr int MR = L == 0 ? MT : ML; const float* W0 = p.w_proj_b + (size_t)L * D * D;
    naive_gemm<1>(w.obr_(), D, MR, D, D, [&](int, int n0) { return WSrc{W0 + n0, nullptr, D}; },
                  [&](int m, int n, float a0, float) { w.mrg_()[(size_t)m * D + n] = f2bf(bf2f(w.ma_()[(size_t)m * D + n]) + a0 * bf2f(w.P_()[(size_t)m * LDP + PGB + n])); }, lds, bid, nblk);
}
template <int L> DI void ph_wo_naive(const Params& p, const Ws& w, int bid, int nblk, unsigned char* lds) {
    constexpr int MR = L == 0 ? MT : ML; const float* W0 = p.w_out + (size_t)L * D * D;
    naive_gemm<1>(w.mrg_(), D, MR, D, D, [&](int, int n0) { return WSrc{W0 + n0, nullptr, D}; },
                  [&](int m, int n, float a0, float) { w.mm_()[(size_t)m * D + n] = f2bf(a0); }, lds, bid, nblk);
}
DI int expert_of_row(const int (&off)[9], int m0) { int e = 0;
#pragma unroll
    for (int q = 1; q < 8; ++q) e = (m0 >= off[q]) ? q : e;
    return e; }
template <int L> DI void ph_f1_naive(const Params& p, const Ws& w, int bid, int nblk, unsigned char* lds) {
    if (L == 0) {
        naive_gemm<2>(w.h_(), D, MT, DFF, D, [&](int, int n0) { return WSrc{p.ffn_w1 + n0, p.ffn_w3 + n0, DFF}; },
                      [&](int m, int n, float a0, float a1) { w.gg_()[(size_t)m * DFF + n] = f2bf(siluf(a0) * a1); }, lds, bid, nblk);
    } else {
        int off[9]; moe_offsets(w, off);
        naive_gemm<2>(w.hs_(), D, off[8], DFF, D, [&](int m0, int n0) { const size_t eo = (size_t)expert_of_row(off, m0) * D * DFF; return WSrc{p.moe_w1 + eo + n0, p.moe_w3 + eo + n0, DFF}; },
                      [&](int m, int n, float a0, float a1) { w.gg_()[(size_t)m * DFF + n] = f2bf(siluf(a0) * a1); }, lds, bid, nblk);
    }
}
template <int L> DI void ph_f2_naive(const Params& p, const Ws& w, int bid, int nblk, unsigned char* lds) {
    if (L == 0) {
        naive_gemm<1>(w.gg_(), DFF, MT, D, DFF, [&](int, int n0) { return WSrc{p.ffn_w2 + n0, nullptr, D}; },
                      [&](int m, int n, float a0, float) { w.mm_()[(size_t)m * D + n] = f2bf(a0); }, lds, bid, nblk);
    } else {
        int off[9]; moe_offsets(w, off);
        naive_gemm<1>(w.gg_(), DFF, off[8], D, DFF, [&](int m0, int n0) { return WSrc{p.moe_w2 + (size_t)expert_of_row(off, m0) * DFF * D + n0, nullptr, D}; },
                      [&](int m, int n, float a0, float) { w.ys_()[(size_t)m * D + n] = f2bf(a0); }, lds, bid, nblk);
    }
}

template <int L> DI void ph_g1_naive(const Params& p, const Ws& w, int bid, int nblk, unsigned char* lds) {
    bf16_t* qt_s = (bf16_t*)lds;
    bf16_t* kt_s = (bf16_t*)(lds + 65536);
    float* A_s = (float*)(lds + 131072);
    float* pg_s = A_s;
    const int tid = threadIdx.x, d = tid >> 8, k = tid & 255;
    for (int u = bid; u < NCH * NH; u += nblk) {
        const int cg = u >> 2, h = u & 3, r0 = cg * 64;
        __syncthreads();
        for (int i = tid; i < 64 * 32; i += 512) pg_s[i] = w.pg_()[(size_t)r0 * 32 + i];
        const float* w2 = (d == 0 ? p.gate_w2_f : p.gate_w2_b) + (size_t)L * 16 * 1024 + h * 256 + k;
        float wv[16];
#pragma unroll
        for (int r = 0; r < 16; ++r) wv[r] = w2[r * 1024];
        const float bias = (d == 0 ? p.gate_b_f : p.gate_b_b)[L * 1024 + h * 256 + k];
        __syncthreads();
        float tot = 0.f;
#pragma unroll 4
        for (int t = 0; t < 64; ++t) { float xg = bias;
#pragma unroll
            for (int r = 0; r < 16; ++r) xg += pg_s[t * 32 + d * 16 + r] * wv[r];
            tot += (fminf(xg, 0.f) - log1pf(__expf(-fabsf(xg)))) * 0.0625f; }
        float cum = 0.f;
#pragma unroll 1
        for (int c = 0; c < 8; ++c) {
            bf16_t kev[8];
#pragma unroll
            for (int i = 0; i < 8; ++i) {
                const int t = d ? 63 - (c * 8 + i) : c * 8 + i;
                float xg = bias;
#pragma unroll
                for (int r = 0; r < 16; ++r) xg += pg_s[t * 32 + d * 16 + r] * wv[r];
                cum += (fminf(xg, 0.f) - log1pf(__expf(-fabsf(xg)))) * 0.0625f;
                const size_t row = (size_t)(r0 + t);
                const float q = bf2f(w.P_()[row * LDP + PQ + h * 256 + k]), kk = bf2f(w.P_()[row * LDP + PK + h * 256 + k]);
                const bf16_t qtv = f2bf(q * __expf(cum)), ktv = f2bf(kk * __expf(-cum));
                kev[i] = f2bf(kk * __expf(tot - cum));
                qt_s[(d * 64 + t) * 256 + k] = qtv; kt_s[(d * 64 + t) * 256 + k] = ktv;
                w.qt_()[((size_t)d * MT + row) * 1024 + h * 256 + k] = qtv;
                asm volatile("" ::: "memory");
            }
            const int t0 = d ? 56 - c * 8 : c * 8;
            uint4 o;
            o.x = d ? ((unsigned)kev[7] | ((unsigned)kev[6] << 16)) : ((unsigned)kev[0] | ((unsigned)kev[1] << 16));
            o.y = d ? ((unsigned)kev[5] | ((unsigned)kev[4] << 16)) : ((unsigned)kev[2] | ((unsigned)kev[3] << 16));
            o.z = d ? ((unsigned)kev[3] | ((unsigned)kev[2] << 16)) : ((unsigned)kev[4] | ((unsigned)kev[5] << 16));
            o.w = d ? ((unsigned)kev[1] | ((unsigned)kev[0] << 16)) : ((unsigned)kev[6] | ((unsigned)kev[7] << 16));
            *(uint4*)(w.ket_() + ((((size_t)d * NCH + cg) * 4 + h) * 256 + k) * 64 + t0) = o;
        }
        w.gd_()[((size_t)d * NCH + cg) * 1024 + h * 256 + k] = __expf(tot);
        __syncthreads();
        { const int t = tid >> 3, s0 = (tid & 7) * 8;
#pragma unroll 1
          for (int j = 0; j < 8; ++j) { const int s = s0 + j; float a = 0.f;
              if (s <= t) { const bf16_t* qa = qt_s + t * 256; const bf16_t* ka = kt_s + s * 256; for (int c = 0; c < 256; ++c) a += bf2f(qa[c]) * bf2f(ka[c]); }
              if (s >= t) { const bf16_t* qa = qt_s + (64 + t) * 256; const bf16_t* ka = kt_s + (64 + s) * 256; for (int c = 0; c < 256; ++c) a += bf2f(qa[c]) * bf2f(ka[c]); }
              A_s[t * 64 + s] = a; } }
        __syncthreads();
        { const int n = tid; float vc[64];
#pragma unroll
          for (int s = 0; s < 64; ++s) vc[s] = bf2f(w.P_()[(size_t)(r0 + s) * LDP + PV + h * 512 + n]);
          { uint4* dst = (uint4*)(w.vt_() + (((size_t)cg * 4 + h) * 512 + n) * 64);
#pragma unroll
            for (int c = 0; c < 8; ++c) { uint4 o4;
                o4.x = (__float_as_uint(vc[c * 8 + 0]) >> 16) | (__float_as_uint(vc[c * 8 + 1]) & 0xffff0000u); o4.y = (__float_as_uint(vc[c * 8 + 2]) >> 16) | (__float_as_uint(vc[c * 8 + 3]) & 0xffff0000u);
                o4.z = (__float_as_uint(vc[c * 8 + 4]) >> 16) | (__float_as_uint(vc[c * 8 + 5]) & 0xffff0000u); o4.w = (__float_as_uint(vc[c * 8 + 6]) >> 16) | (__float_as_uint(vc[c * 8 + 7]) & 0xffff0000u);
                dst[c] = o4; } }
          for (int t = 0; t < 64; ++t) { float o = 0.f;
#pragma unroll
              for (int s = 0; s < 64; ++s) o += A_s[t * 64 + s] * vc[s];
              w.oi_()[(size_t)(r0 + t) * D + h * 512 + n] = f2bf(o); } }
    }
}
template <int L> DI void ph_g2_naive(const Params& p, const Ws& w, int bid, int nblk, unsigned char* lds) {
    float* S = (float*)lds;
    bf16_t* qt_s = (bf16_t*)(lds + 65536);
    bf16_t* ke_s = (bf16_t*)(lds + 98304);
    float* g_s = (float*)(lds + 131072);
    const int tid = threadIdx.x, n = tid & 63, tq = tid >> 6;
    for (int u = bid; u < 256; u += nblk) {
        const int j = u & 7, d = (u >> 3) & 1, h = (u >> 4) & 3, b = u >> 6;
        __syncthreads();
        for (int i = tid; i < 256 * 64; i += 512) S[i] = 0.f;
        for (int step = 0; step < 36; ++step) {
            int cg; if (step < 4) cg = 128 + b * 4 + (d ? 3 - step : step); else { const int c = step - 4; cg = b * 32 + (d ? 31 - c : c); }
            const int r0 = cg * 64;
            __syncthreads();
#pragma unroll
            for (int i = 0; i < 4; ++i) { const int idx = tid + i * 512, t = idx >> 5, kc = idx & 31;
                *(uint4*)(qt_s + t * 256 + kc * 8) = *(const uint4*)(w.qt_() + ((size_t)d * MT + r0 + t) * 1024 + h * 256 + kc * 8); }
            { const uint4* src = (const uint4*)(w.ket_() + (((size_t)d * NCH + cg) * 4 + h) * 256 * 64);
#pragma unroll
              for (int i = 0; i < 4; ++i) ((uint4*)ke_s)[tid + i * 512] = src[tid + i * 512]; }
            if (tid < 256) g_s[tid] = w.gd_()[((size_t)d * NCH + cg) * 1024 + h * 256 + tid];
            float vc[64];
            { const uint4* src = (const uint4*)(w.vt_() + (((size_t)cg * 4 + h) * 512 + j * 64 + n) * 64);
#pragma unroll
              for (int c = 0; c < 8; ++c) { const uint4 v = src[c];
                  vc[c * 8 + 0] = __uint_as_float(v.x << 16); vc[c * 8 + 1] = __uint_as_float(v.x & 0xffff0000u); vc[c * 8 + 2] = __uint_as_float(v.y << 16); vc[c * 8 + 3] = __uint_as_float(v.y & 0xffff0000u);
                  vc[c * 8 + 4] = __uint_as_float(v.z << 16); vc[c * 8 + 5] = __uint_as_float(v.z & 0xffff0000u); vc[c * 8 + 6] = __uint_as_float(v.w << 16); vc[c * 8 + 7] = __uint_as_float(v.w & 0xffff0000u); } }
            __syncthreads();
            { float acc[8] = {0.f, 0.f, 0.f, 0.f, 0.f, 0.f, 0.f, 0.f};
              for (int kk = 0; kk < 256; ++kk) { const float s = S[kk * 64 + n];
#pragma unroll
                  for (int i = 0; i < 8; ++i) acc[i] += bf2f(qt_s[(tq * 8 + i) * 256 + kk]) * s; }
#pragma unroll
              for (int i = 0; i < 8; ++i) w.of_()[((size_t)d * MT + r0 + tq * 8 + i) * D + h * 512 + j * 64 + n] = f2bf(acc[i]); }
            __syncthreads();
            for (int i = 0; i < 32; ++i) { const int kk = tq * 32 + i; float s = g_s[kk] * S[kk * 64 + n];
#pragma unroll
                for (int t = 0; t < 64; ++t) s += bf2f(ke_s[kk * 64 + t]) * vc[t];
                S[kk * 64 + n] = s; }
        }
    }
}

#define XB_TMO      128
#define XB_XCNT(j)  (256  + 64 * (j))
#define XB_XSUB(j)  (1280 + 64 * (j))
#define XB_XGEN(j)  (2304 + 64 * (j))
#define XB_TOP      3328
#define XB_TOPGEN   3392
#define XCD_BAR_WORDS 3456
#define XB_SPIN_CAP (1u << 18)
#define LAS __attribute__((address_space(3)))

__device__ __forceinline__ unsigned xb_ld(unsigned* p)              { return __hip_atomic_load(p, __ATOMIC_RELAXED, __HIP_MEMORY_SCOPE_AGENT); }
__device__ __forceinline__ unsigned xb_add(unsigned* p, unsigned v) { return __hip_atomic_fetch_add(p, v, __ATOMIC_RELAXED, __HIP_MEMORY_SCOPE_AGENT); }
__device__ __forceinline__ unsigned xb_xcc_id() { return (unsigned)__builtin_amdgcn_s_getreg((3 << 11) | 20) & 0xFu; }
#define XB_SPIN(cond, bar) do { unsigned _sp = 0; while (cond) { __builtin_amdgcn_s_sleep(1); \
    if ((++_sp & 255u) == 0u) { if (xb_ld(&(bar)[XB_TMO])) break; if (_sp > XB_SPIN_CAP) { atomicAdd(&(bar)[XB_TMO], 1u); break; } } } } while (0)

struct XcdBarrier {
    unsigned* bar; unsigned x;
    volatile LAS unsigned* st;
};

__device__ __forceinline__ XcdBarrier xcd_barrier_post(unsigned* bar, volatile LAS unsigned* st) {
    XcdBarrier b; b.bar = bar; b.x = xb_xcc_id(); b.st = st;
    if (threadIdx.x == 0) (void)xb_add(&bar[XB_XCNT(b.x)], 1u);
    return b;
}
__device__ __forceinline__ void xcd_barrier_complete(unsigned* bar, unsigned x, unsigned& nloc, unsigned& nx) {
    const unsigned G = gridDim.x * gridDim.y * gridDim.z;
    unsigned sum, cnt, mine, sp = 0u;
    for (;;) {
        sum = 0u; cnt = 0u; mine = 0u;
#pragma unroll
        for (unsigned j = 0; j < 16; ++j) { const unsigned c = xb_ld(&bar[XB_XCNT(j)]); sum += c; cnt += (c > 0u) ? 1u : 0u; mine = (j == x) ? c : mine; }
        if (sum == G) break;
        __builtin_amdgcn_s_sleep(1);
        if ((++sp & 255u) == 0u) { if (xb_ld(&bar[XB_TMO])) break; if (sp > XB_SPIN_CAP) { atomicAdd(&bar[XB_TMO], 1u); break; } }
    }
    nloc = mine > 0u ? mine : 1u; nx = cnt > 0u ? cnt : 1u;
}

__device__ __forceinline__ void xcd_barrier(const XcdBarrier& b) {
    asm volatile("s_waitcnt vmcnt(0)" ::: "memory");
    __syncthreads();
    if (threadIdx.x == 0) {
        unsigned* bar = b.bar;
        __builtin_amdgcn_s_waitcnt(0);
        unsigned nloc = b.st[0], nx = b.st[1];
        if (nloc == 0u) { xcd_barrier_complete(bar, b.x, nloc, nx); b.st[0] = nloc; b.st[1] = nx; }
        const unsigned old = xb_add(&bar[XB_XSUB(b.x)], 1u);
        const unsigned gen = old / nloc;
        if (old + 1u == (gen + 1u) * nloc) {
            __builtin_amdgcn_fence(__ATOMIC_RELEASE, "agent");
            asm volatile("s_waitcnt vmcnt(0)" ::: "memory");
            const unsigned og = xb_add(&bar[XB_TOP], 1u);
            const unsigned tg = og / nx;
            if (og + 1u == (tg + 1u) * nx) xb_add(&bar[XB_TOPGEN], 1u);
            else XB_SPIN(xb_ld(&bar[XB_TOPGEN]) == tg, bar);
            __builtin_amdgcn_fence(__ATOMIC_ACQUIRE, "agent");
            xb_add(&bar[XB_XGEN(b.x)], 1u);
            asm volatile("s_waitcnt vmcnt(0)" ::: "memory");
        } else {
            XB_SPIN(xb_ld(&bar[XB_XGEN(b.x)]) == gen, bar);
            __builtin_amdgcn_fence(__ATOMIC_ACQUIRE, "agent");
            asm volatile("s_waitcnt vmcnt(0)" ::: "memory");
        }
    }
    __syncthreads();
}


namespace pg8 {
#define PG8_LAS __attribute__((address_space(3)))
typedef unsigned short bf16_t;
typedef short bf16x8 __attribute__((ext_vector_type(8)));
typedef float f32x4 __attribute__((ext_vector_type(4)));
typedef unsigned u32x4 __attribute__((ext_vector_type(4)));
constexpr int BM = 256, BK = 64, HALF = 128, HTB = HALF * BK * 2  , STAGE_BYTES = 8 * HTB, NXCD = 8, WGM = 8;

__host__ __device__ __forceinline__ int lds_byte(int r, int c) { const int st = (r >> 4) * 2 + (c >> 5), rr = r & 15, cc = c & 31, ob = rr * 64 + cc * 2; return st * 1024 + (ob ^ (((ob >> 9) & 1) << 5)); }
__host__ __device__ __forceinline__ void stage_rc(int b, int& R, int& C) { const int st = b / 1024, sb = b % 1024, swz = sb ^ (((sb >> 9) & 1) << 5); R = (st >> 1) * 16 + swz / 64; C = (st & 1) * 32 + (swz % 64) / 2; }
__host__ __device__ __forceinline__ int perm32(int rho) { const int n = rho >> 4, i = rho & 15; return 8 * (i >> 2) + 4 * n + (i & 3); }

struct Unit { int pm, pn, ks; };
struct Gemm { const bf16_t* A; const bf16_t* Bt; int M, N, K; };

struct StaticOrder {
    int nM, nN, nwg, G, c;
    __host__ __device__ __forceinline__ void init(int M, int N, int G_, int c_) { nM = M / BM; nN = N / BM; nwg = nM * nN; G = G_; c = c_; }
    __host__ __device__ __forceinline__ bool next(int i, Unit& u) const {
        const long L = (long)i * G + c; if (L >= nwg) return false;
        int wgid = (int)L; { const int q = nwg / NXCD, r = nwg % NXCD, xcd = wgid % NXCD, off = wgid / NXCD; wgid = (xcd < r ? xcd * (q + 1) : r * (q + 1) + (xcd - r) * q) + off; }
        const int nig = WGM * nN, gid = wgid / nig, fm = gid * WGM, gsz = (nM - fm) < WGM ? (nM - fm) : WGM;
        u.pm = fm + ((wgid % nig) % gsz); u.pn = (wgid % nig) / gsz; u.ks = -1; return true;
    }
    __device__ __forceinline__ void a_ready(const Unit&) const {}
    __device__ __forceinline__ void done(const Unit&) const {}
    __device__ __forceinline__ int koff(const Unit&) const { return 0; }
    __device__ __forceinline__ int ntiles(const Unit&, int nt_full) const { return nt_full; }
};

typedef __bf16 bf2_t __attribute__((ext_vector_type(2)));
typedef float f2_t __attribute__((ext_vector_type(2)));
__device__ __forceinline__ unsigned cvt_pk_bf16(float lo, float hi) { const f2_t f = {lo, hi}; const bf2_t b = __builtin_convertvector(f, bf2_t); return __builtin_bit_cast(unsigned, b); }
template <class Epi, class Sched, bool ALIGN_EPI = false, bool SP2 = false>
__device__ __forceinline__ void gemm_phase(PG8_LAS unsigned char* lds, const Gemm g, const Sched& S, const Epi& E) {
    const int tid = threadIdx.x, wid = __builtin_amdgcn_readfirstlane(tid >> 6), lane = tid & 63, wr = wid >> 2, wc = wid & 3, fr = lane & 15, fq = lane >> 4;
    const int K = g.K, nt_full = K / BK;
    unsigned voffA[2], voffB[2];
#pragma unroll
    for (int i = 0; i < 2; ++i) { int R, C; stage_rc(tid * 16 + i * 8192, R, C); const int Rb = Epi::PERM ? ((R & ~31) + perm32(R & 31)) : R;
        voffA[i] = (unsigned)(R * K + C) * 2u; voffB[i] = (unsigned)(Rb * K + C) * 2u; }
    const size_t kstep = (size_t)(BK * 2);
    const size_t hstep = (size_t)HALF * K * 2;
    const size_t tstep = 2 * hstep;
    const unsigned ldsw = (unsigned)wid * 1024u;
    const int aoff = lds_byte(wr * 64 + fr, fq * 8), boff = lds_byte(wc * 32 + fr, fq * 8);
#define PG8_SA(b, h) (((b) * 2 + (h)) * HTB)
#define PG8_SB(b, h) ((4 + (b) * 2 + (h)) * HTB)
#define PG8_STAGE(bufoff, gbase, voff) do { _Pragma("unroll") for (int _i = 0; _i < 2; ++_i) \
        __builtin_amdgcn_global_load_lds((const unsigned*)((const char*)(gbase) + (voff)[_i]), (PG8_LAS unsigned*)(lds + (bufoff) + ldsw + _i * 8192), 16, 0, 0); } while (0)
#define PG8_LDA(dst, b, h) do { _Pragma("unroll") for (int m = 0; m < 4; ++m) _Pragma("unroll") for (int k = 0; k < 2; ++k) dst[m][k] = *(const PG8_LAS bf16x8*)(lds + PG8_SA(b, h) + aoff + m * 2048 + k * 1024); } while (0)
#define PG8_LDB(dst, b, h) do { _Pragma("unroll") for (int n = 0; n < 2; ++n) _Pragma("unroll") for (int k = 0; k < 2; ++k) dst[n][k] = *(const PG8_LAS bf16x8*)(lds + PG8_SB(b, h) + boff + n * 2048 + k * 1024); } while (0)
#define PG8_MMA(ai, bj, At, Bt) do { __builtin_amdgcn_s_setprio(1); _Pragma("unroll") for (int m = 0; m < 4; ++m) _Pragma("unroll") for (int n = 0; n < 2; ++n) _Pragma("unroll") for (int k = 0; k < 2; ++k) \
        acc[ai][bj][m][n] = __builtin_amdgcn_mfma_f32_16x16x32_bf16(Bt[n][k], At[m][k], acc[ai][bj][m][n], 0, 0, 0); __builtin_amdgcn_s_setprio(0); } while (0)
#define PG8_WAIT_V(n) asm volatile("s_waitcnt vmcnt(" #n ")" ::: "memory")
#define PG8_WAIT_L(n) asm volatile("s_waitcnt lgkmcnt(" #n ")" ::: "memory")
#define PG8_WAIT_V8R(flag) do { \
    if constexpr (Epi::NST == 16) asm volatile("s_cmp_eq_u32 %0, 0\n\ts_cbranch_scc1 .Lwa%=\n\ts_waitcnt vmcnt(24)\n\ts_branch .Lwb%=\n.Lwa%=:\n\ts_waitcnt vmcnt(8)\n.Lwb%=:" :: "s"(flag) : "scc", "memory"); \
    else if constexpr (Epi::NST == 8) asm volatile("s_cmp_eq_u32 %0, 0\n\ts_cbranch_scc1 .Lwa%=\n\ts_waitcnt vmcnt(16)\n\ts_branch .Lwb%=\n.Lwa%=:\n\ts_waitcnt vmcnt(8)\n.Lwb%=:" :: "s"(flag) : "scc", "memory"); \
    else PG8_WAIT_V(8); } while (0)
#define PG8_BAR __builtin_amdgcn_s_barrier()
#define PG8_SCHED __builtin_amdgcn_sched_barrier(0)
    Unit cur, nxt; int ui = 0;
    if (!S.next(0, cur)) return;
    f32x4 acc[2][2][4][2];
#pragma unroll
    for (int a = 0; a < 2; ++a)
#pragma unroll
        for (int b = 0; b < 2; ++b)
#pragma unroll
            for (int m = 0; m < 4; ++m)
#pragma unroll
                for (int n = 0; n < 2; ++n) acc[a][b][m][n] = (f32x4){0.f, 0.f, 0.f, 0.f};
    bf16x8 At[4][2], B0[2][2], B1[2][2];
    const char* cA = (const char*)g.A + (size_t)cur.pm * tstep + (size_t)S.koff(cur) * 2; const char* cB = (const char*)g.Bt + (size_t)cur.pn * tstep + (size_t)S.koff(cur) * 2;
    S.a_ready(cur);
    if constexpr (SP2) {
        PG8_STAGE(PG8_SB(0, 0), cB, voffB); PG8_STAGE(PG8_SB(0, 1), cB + hstep, voffB); PG8_STAGE(PG8_SA(0, 0), cA, voffA); PG8_STAGE(PG8_SA(0, 1), cA + hstep, voffA);
        if (wr == 1) PG8_BAR;
        PG8_WAIT_V(2); PG8_BAR;
        PG8_STAGE(PG8_SB(1, 0), cB + kstep, voffB); PG8_STAGE(PG8_SA(1, 0), cA + kstep, voffA); PG8_STAGE(PG8_SB(1, 1), cB + hstep + kstep, voffB);
        PG8_WAIT_V(6); PG8_BAR;
    } else {
        PG8_STAGE(PG8_SB(0, 0), cB, voffB); PG8_STAGE(PG8_SA(0, 0), cA, voffA); PG8_STAGE(PG8_SB(0, 1), cB + hstep, voffB); PG8_STAGE(PG8_SA(0, 1), cA + hstep, voffA);
        if (wr == 1) PG8_BAR;
        PG8_WAIT_V(4); PG8_BAR;
        PG8_STAGE(PG8_SB(1, 0), cB + kstep, voffB); PG8_STAGE(PG8_SA(1, 0), cA + kstep, voffA); PG8_STAGE(PG8_SB(1, 1), cB + hstep + kstep, voffB);
        PG8_WAIT_V(6); PG8_BAR;
    }
    for (;;) {
        const bool has_next = S.next(ui + 1, nxt);
        const char* nA = has_next ? (const char*)g.A + (size_t)nxt.pm * tstep + (size_t)S.koff(nxt) * 2 : cA; const char* nB = has_next ? (const char*)g.Bt + (size_t)nxt.pn * tstep + (size_t)S.koff(nxt) * 2 : cB;
        const int nt = S.ntiles(cur, nt_full);
        for (int t = 0; t < nt; t += 2) {
            const bool last = (t == nt - 2);
            const char* a1 = cA + (size_t)(t + 1) * kstep;
            const char* a2 = last ? nA : cA + (size_t)(t + 2) * kstep; const char* b2 = last ? nB : cB + (size_t)(t + 2) * kstep;
            const char* a3 = a2 + kstep; const char* b3 = b2 + kstep;
            if (last && has_next) S.a_ready(nxt);
            if constexpr (SP2) {
            const int rflag = __builtin_amdgcn_readfirstlane((t == 0 && ui > 0) ? 1 : 0);
            PG8_LDB(B0, 0, 0); PG8_LDB(B1, 0, 1); PG8_SCHED; PG8_LDA(At, 0, 0); PG8_STAGE(PG8_SA(1, 1), a1 + hstep, voffA);
            PG8_WAIT_V8R(rflag); PG8_WAIT_L(0); PG8_BAR; PG8_MMA(0, 0, At, B0); PG8_MMA(0, 1, At, B1); PG8_BAR; PG8_SCHED;
            PG8_LDA(At, 0, 1); PG8_STAGE(PG8_SB(0, 0), b2, voffB); PG8_STAGE(PG8_SB(0, 1), b2 + hstep, voffB); PG8_STAGE(PG8_SA(0, 0), a2, voffA);
            PG8_WAIT_V8R(rflag); PG8_WAIT_L(0); PG8_BAR; PG8_MMA(1, 0, At, B0); PG8_MMA(1, 1, At, B1); PG8_BAR; PG8_SCHED;
            PG8_LDB(B0, 1, 0); PG8_LDB(B1, 1, 1); PG8_SCHED; PG8_LDA(At, 1, 0); PG8_STAGE(PG8_SA(0, 1), a2 + hstep, voffA);
            PG8_WAIT_V(8); PG8_WAIT_L(0); PG8_BAR; PG8_MMA(0, 0, At, B0); PG8_MMA(0, 1, At, B1); PG8_BAR; PG8_SCHED;
            PG8_LDA(At, 1, 1); PG8_STAGE(PG8_SB(1, 0), b3, voffB); PG8_STAGE(PG8_SB(1, 1), b3 + hstep, voffB); PG8_STAGE(PG8_SA(1, 0), a3, voffA);
            PG8_WAIT_V(8); PG8_WAIT_L(0); PG8_BAR; PG8_MMA(1, 0, At, B0); PG8_MMA(1, 1, At, B1); PG8_BAR; PG8_SCHED;
            } else {
            PG8_LDB(B0, 0, 0); PG8_SCHED; PG8_LDA(At, 0, 0); PG8_STAGE(PG8_SA(1, 1), a1 + hstep, voffA);
            PG8_WAIT_L(8); PG8_BAR; PG8_WAIT_L(0); PG8_MMA(0, 0, At, B0); PG8_BAR; PG8_SCHED;
            PG8_LDB(B1, 0, 1); PG8_STAGE(PG8_SB(0, 0), b2, voffB);
            PG8_BAR; PG8_WAIT_L(0); PG8_MMA(0, 1, At, B1); PG8_BAR;
            PG8_LDA(At, 0, 1); PG8_STAGE(PG8_SA(0, 0), a2, voffA);
            PG8_BAR; PG8_WAIT_L(0); PG8_MMA(1, 0, At, B0); PG8_BAR; PG8_SCHED;
            PG8_STAGE(PG8_SB(0, 1), b2 + hstep, voffB);
            PG8_WAIT_V(6); PG8_BAR; PG8_MMA(1, 1, At, B1); PG8_BAR;
            PG8_LDB(B0, 1, 0); PG8_SCHED; PG8_LDA(At, 1, 0); PG8_STAGE(PG8_SA(0, 1), a2 + hstep, voffA);
            PG8_WAIT_L(8); PG8_BAR; PG8_WAIT_L(0); PG8_MMA(0, 0, At, B0); PG8_BAR; PG8_SCHED;
            PG8_LDB(B1, 1, 1); PG8_STAGE(PG8_SB(1, 0), b3, voffB);
            PG8_BAR; PG8_WAIT_L(0); PG8_MMA(0, 1, At, B1); PG8_BAR;
            PG8_LDA(At, 1, 1); PG8_STAGE(PG8_SA(1, 0), a3, voffA);
            PG8_BAR; PG8_WAIT_L(0); PG8_MMA(1, 0, At, B0); PG8_BAR; PG8_SCHED;
            PG8_STAGE(PG8_SB(1, 1), b3 + hstep, voffB);
            PG8_WAIT_V(6); PG8_BAR; PG8_MMA(1, 1, At, B1); PG8_BAR;
            }
        }
        if constexpr (ALIGN_EPI) { if (wr == 0) PG8_BAR; }
        if constexpr (!Epi::AFTER_DRAIN) { E(acc, cur, wr, wc, fr, fq); S.done(cur); }
        if (!has_next) break;
#pragma unroll
        for (int a = 0; a < 2; ++a)
#pragma unroll
            for (int b = 0; b < 2; ++b)
#pragma unroll
                for (int m = 0; m < 4; ++m)
#pragma unroll
                    for (int n = 0; n < 2; ++n) acc[a][b][m][n] = (f32x4){0.f, 0.f, 0.f, 0.f};
        cur = nxt; cA = nA; cB = nB; ++ui;
        if constexpr (ALIGN_EPI) { if (wr == 1) PG8_BAR; }
    }
    PG8_WAIT_V(0);
    if constexpr (!ALIGN_EPI) { if (wr == 0) PG8_BAR; }
    PG8_BAR;
    if constexpr (Epi::AFTER_DRAIN) { E.fused(acc, cur, wr, wc, fr, fq, lds, wid, lane); S.done(cur); }
#undef PG8_SA
#undef PG8_SB
#undef PG8_STAGE
#undef PG8_LDA
#undef PG8_LDB
#undef PG8_MMA
#undef PG8_WAIT_V
#undef PG8_WAIT_L
#undef PG8_BAR
#undef PG8_SCHED
}
}

using pg8::Unit; using pg8::Gemm;
typedef unsigned u32x4 __attribute__((ext_vector_type(4)));
typedef unsigned u32x2 __attribute__((ext_vector_type(2)));
DI float fsig(float v) { return __builtin_amdgcn_rcpf(1.f + __expf(-v)); }
DI f32x4 unpack4(u32x2 g) { return (f32x4){__uint_as_float(g.x << 16), __uint_as_float(g.x & 0xffff0000u), __uint_as_float(g.y << 16), __uint_as_float(g.y & 0xffff0000u)}; }

struct RectOrder : pg8::StaticOrder {
    int xM, xN, xwg;
    DI void init2(int M, int N, int G_, int c_, int xM_, int xN_) { init(M, N, G_, c_); xM = xM_; xN = xN_; xwg = xM_ * xN_; }
    DI bool next(int i, Unit& u) const {
        const long Lx = (long)i * G + c;
        if (Lx < nwg) return pg8::StaticOrder::next(i, u);
        if (Lx >= nwg + xwg) return false;
        const int l2 = (int)(Lx - nwg); u.pm = nM + l2 % xM; u.pn = l2 / xM; u.ks = -1; return true;
    }
};
struct SplitOrder : pg8::StaticOrder {
    int xM, xwg, kq;
    DI void init2(int M, int N, int G_, int c_, int xM_, int K) { init(M, N, G_, c_); xM = xM_; xwg = xM_ * nN * 4; kq = K / 4; }
    DI bool next(int i, Unit& u) const {
        const long Lx = (long)i * G + c;
        if (Lx < nwg) return pg8::StaticOrder::next(i, u);
        if (Lx >= nwg + xwg) return false;
        const int l2 = (int)(Lx - nwg), sl = l2 & 3, tile = l2 >> 2; u.pm = nM + tile % xM; u.pn = tile / xM; u.ks = sl; return true;
    }
    DI int koff(const Unit& u) const { return u.ks < 0 ? 0 : u.ks * kq; }
    DI int ntiles(const Unit& u, int nt_full) const { return u.ks < 0 ? nt_full : kq / 64; }
};
template <bool SPLIT> struct MoeOrderT : SplitOrder {
    const LAS unsigned char* pe;
    DI bool next(int i, Unit& u) const { if (SPLIT ? !SplitOrder::next(i, u) : !pg8::StaticOrder::next(i, u)) return false; u.pn += (int)pe[u.pm] * nN; return true; }
};
typedef MoeOrderT<false> MoeOrder;

DI u32x4 ror8(const u32x4 v) { u32x4 r;
    r.x = (unsigned)__builtin_amdgcn_update_dpp(0, (int)v.x, 0x128, 0xF, 0xF, false); r.y = (unsigned)__builtin_amdgcn_update_dpp(0, (int)v.y, 0x128, 0xF, 0xF, false);
    r.z = (unsigned)__builtin_amdgcn_update_dpp(0, (int)v.z, 0x128, 0xF, 0xF, false); r.w = (unsigned)__builtin_amdgcn_update_dpp(0, (int)v.w, 0x128, 0xF, 0xF, false); return r; }
DI void st_lines(bf16_t* base, size_t ld8, bool hi, const u32x4 x, const u32x4 y) {
    const u32x4 r = ror8(hi ? x : y);
    *(u32x4*)base = hi ? r : x; *(u32x4*)(base + ld8) = hi ? y : r;
}
struct EpiInproj {
    static constexpr bool PERM = true, AFTER_DRAIN = false; static constexpr int NST = 8;
    bf16_t* P;
    DI void operator()(const f32x4 (&acc)[2][2][4][2], const Unit& u, int wr, int wc, int fr, int fq) const {
        const int pn = u.pn, row0 = u.pm * 256 + wr * 64 + fr;
        if (pn >= 32 && pn < 48) {
            const int col = PU + 128 * (pn - 32) + wc * 32 + 8 * fq;
#pragma unroll
            for (int ai = 0; ai < 2; ++ai)
#pragma unroll
                for (int m = 0; m < 4; ++m) { const f32x4 v0 = acc[ai][0][m][0] * acc[ai][1][m][0], v1 = acc[ai][0][m][1] * acc[ai][1][m][1];
                    u32x4 o; o.x = pg8::cvt_pk_bf16(v0[0], v0[1]); o.y = pg8::cvt_pk_bf16(v0[2], v0[3]); o.z = pg8::cvt_pk_bf16(v1[0], v1[1]); o.w = pg8::cvt_pk_bf16(v1[2], v1[3]);
                    *(u32x4*)(P + (size_t)(row0 + ai * 128 + m * 16) * LDP + col) = o; }
        } else {
            const bool hi = fr >= 8;
            bf16_t* pb = P + (size_t)(row0 - (hi ? 8 : 0)) * LDP + (pn < 32 ? 256 * pn : 256 * (pn - 8)) + wc * 64 + 8 * fq + (hi ? 32 : 0);
            const int act = (pn >= 16 && pn < 24) ? 1 : (pn >= 48 ? 2 : 0);
#pragma unroll
            for (int ai = 0; ai < 2; ++ai)
#pragma unroll
                for (int m = 0; m < 4; ++m) { u32x4 o[2];
#pragma unroll
                    for (int bj = 0; bj < 2; ++bj) { f32x4 v0 = acc[ai][bj][m][0], v1 = acc[ai][bj][m][1];
                        if (act) {
#pragma unroll
                            for (int j = 0; j < 4; ++j) { const float s0 = fsig(v0[j]), s1 = fsig(v1[j]); v0[j] = act == 1 ? v0[j] * s0 : s0; v1[j] = act == 1 ? v1[j] * s1 : s1; } }
                        o[bj].x = pg8::cvt_pk_bf16(v0[0], v0[1]); o[bj].y = pg8::cvt_pk_bf16(v0[2], v0[3]); o[bj].z = pg8::cvt_pk_bf16(v1[0], v1[1]); o[bj].w = pg8::cvt_pk_bf16(v1[2], v1[3]); }
                    st_lines(pb + (size_t)(ai * 128 + m * 16) * LDP, (size_t)8 * LDP, hi, o[0], o[1]); }
        }
    }
};
DI u32x4 pack8(const f32x4 v0, const f32x4 v1) { u32x4 o; o.x = pg8::cvt_pk_bf16(v0[0], v0[1]); o.y = pg8::cvt_pk_bf16(v0[2], v0[3]); o.z = pg8::cvt_pk_bf16(v1[0], v1[1]); o.w = pg8::cvt_pk_bf16(v1[2], v1[3]); return o; }
struct EpiGateA {
    static constexpr bool PERM = true, AFTER_DRAIN = false; static constexpr int NST = 16;
    bf16_t* out; const bf16_t* P; int gcol;
    DI void operator()(const f32x4 (&acc)[2][2][4][2], const Unit& u, int wr, int wc, int fr, int fq) const {
        const int row0 = u.pm * 256 + wr * 64 + fr, col0 = u.pn * 256 + wc * 64 + 8 * fq; const bool hi = fr >= 8;
        bf16_t* ob = out + (size_t)(row0 - (hi ? 8 : 0)) * D + col0 + (hi ? 32 : 0);
#pragma unroll
        for (int ai = 0; ai < 2; ++ai)
#pragma unroll
            for (int m = 0; m < 4; ++m) { const size_t r = (size_t)(row0 + ai * 128 + m * 16); u32x4 o[2];
#pragma unroll
                for (int bj = 0; bj < 2; ++bj) { const int c = col0 + bj * 32; const u32x4 gq = *(const u32x4*)(P + r * LDP + gcol + c);
                    o[bj] = pack8(acc[ai][bj][m][0] * unpack4((u32x2){gq.x, gq.y}), acc[ai][bj][m][1] * unpack4((u32x2){gq.z, gq.w})); }
                st_lines(ob + (size_t)(ai * 128 + m * 16) * D, (size_t)8 * D, hi, o[0], o[1]); }
    }
};
struct EpiGateB {
    static constexpr bool PERM = true, AFTER_DRAIN = false; static constexpr int NST = 16;
    bf16_t* out; const bf16_t* ma; const bf16_t* P; int gcol;
    DI void operator()(const f32x4 (&acc)[2][2][4][2], const Unit& u, int wr, int wc, int fr, int fq) const {
        const int row0 = u.pm * 256 + wr * 64 + fr, col0 = u.pn * 256 + wc * 64 + 8 * fq; const bool hi = fr >= 8;
        bf16_t* ob = out + (size_t)(row0 - (hi ? 8 : 0)) * D + col0 + (hi ? 32 : 0);
#pragma unroll
        for (int ai = 0; ai < 2; ++ai)
#pragma unroll
            for (int m = 0; m < 4; ++m) { const size_t r = (size_t)(row0 + ai * 128 + m * 16); u32x4 o[2];
#pragma unroll
                for (int bj = 0; bj < 2; ++bj) { const int c = col0 + bj * 32;
                    const u32x4 gq = *(const u32x4*)(P + r * LDP + gcol + c), aq = *(const u32x4*)(ma + r * D + c);
                    const f32x4 v0 = unpack4((u32x2){aq.x, aq.y}) + acc[ai][bj][m][0] * unpack4((u32x2){gq.x, gq.y}), v1 = unpack4((u32x2){aq.z, aq.w}) + acc[ai][bj][m][1] * unpack4((u32x2){gq.z, gq.w});
                    o[bj] = pack8(v0, v1); }
                st_lines(ob + (size_t)(ai * 128 + m * 16) * D, (size_t)8 * D, hi, o[0], o[1]); }
    }
};
struct EpiF32 {
    static constexpr bool PERM = true, AFTER_DRAIN = false; static constexpr int NST = 16;
    bf16_t* out; float* part; int row0p, prows;
    DI void operator()(const f32x4 (&acc)[2][2][4][2], const Unit& u, int wr, int wc, int fr, int fq) const {
        const int row0 = u.pm * 256 + wr * 64 + fr, col0 = (u.pn & 7) * 256 + wc * 64 + 8 * fq;
        if (u.ks < 0) {
            const bool hi = fr >= 8; bf16_t* ob = out + (size_t)(row0 - (hi ? 8 : 0)) * D + col0 + (hi ? 32 : 0);
#pragma unroll
            for (int ai = 0; ai < 2; ++ai)
#pragma unroll
                for (int m = 0; m < 4; ++m) st_lines(ob + (size_t)(ai * 128 + m * 16) * D, (size_t)8 * D, hi, pack8(acc[ai][0][m][0], acc[ai][0][m][1]), pack8(acc[ai][1][m][0], acc[ai][1][m][1]));
        } else {
            float* base = part + ((size_t)u.ks * prows + (row0 - row0p)) * D + col0;
#pragma unroll
            for (int ai = 0; ai < 2; ++ai)
#pragma unroll
                for (int m = 0; m < 4; ++m)
#pragma unroll
                    for (int bj = 0; bj < 2; ++bj) { float* rp = base + (size_t)(ai * 128 + m * 16) * D + bj * 32; *(f32x4*)rp = acc[ai][bj][m][0]; *(f32x4*)(rp + 4) = acc[ai][bj][m][1]; }
        }
    }
};
struct EpiSwiglu {
    static constexpr bool PERM = true, AFTER_DRAIN = false; static constexpr int NST = 8;
    bf16_t* out;
    DI void operator()(const f32x4 (&acc)[2][2][4][2], const Unit& u, int wr, int wc, int fr, int fq) const {
        const int row0 = u.pm * 256 + wr * 64 + fr, col = (u.pn % 44) * 128 + wc * 32 + 8 * fq;
#pragma unroll
        for (int ai = 0; ai < 2; ++ai)
#pragma unroll
            for (int m = 0; m < 4; ++m) { f32x4 v0, v1;
#pragma unroll
                for (int j = 0; j < 4; ++j) { const float a0 = acc[ai][0][m][0][j], a1 = acc[ai][0][m][1][j]; v0[j] = a0 * fsig(a0) * acc[ai][1][m][0][j]; v1[j] = a1 * fsig(a1) * acc[ai][1][m][1][j]; }
                u32x4 o; o.x = pg8::cvt_pk_bf16(v0[0], v0[1]); o.y = pg8::cvt_pk_bf16(v0[2], v0[3]); o.z = pg8::cvt_pk_bf16(v1[0], v1[1]); o.w = pg8::cvt_pk_bf16(v1[2], v1[3]);
                *(u32x4*)(out + (size_t)(row0 + ai * 128 + m * 16) * DFF + col) = o; }
    }
};

DI void conv_tile(const float* __restrict__ src, int ld, bf16_t* __restrict__ dst, int K, int k0, float scale, float* tile  ) {
    const int tid = threadIdx.x;
    __syncthreads();
#pragma unroll
    for (int ps = 0; ps < 4; ++ps) { const int kr = ps * 32 + (tid >> 4), c4 = (tid & 15) * 4;
        const float4 v = *(const float4*)(src + (size_t)(k0 + kr) * ld + c4);
        float* t = tile + kr * 65 + c4; t[0] = v.x; t[1] = v.y; t[2] = v.z; t[3] = v.w; }
    __syncthreads();
#pragma unroll
    for (int ps = 0; ps < 2; ++ps) { const int n = ps * 32 + (tid >> 4), kc = (tid & 15) * 8; const float* t = tile + kc * 65 + n;
        u32x4 o; o.x = pg8::cvt_pk_bf16(t[0] * scale, t[65] * scale); o.y = pg8::cvt_pk_bf16(t[130] * scale, t[195] * scale);
        o.z = pg8::cvt_pk_bf16(t[260] * scale, t[325] * scale); o.w = pg8::cvt_pk_bf16(t[390] * scale, t[455] * scale);
        *(u32x4*)(dst + (size_t)n * K + k0 + kc) = o; }
}
DI int win_src_col(int vn) {
    if (vn < 4096) return vn;
    if (vn < 6144) return OFF_R + vn - 4096;
    if (vn < 8192) return OFF_CB + vn - 6144;
    if (vn < 12288) { const int t = (vn - 8192) >> 8, wi = (vn - 8192) & 255; return wi < 128 ? OFF_CC + 128 * t + wi : OFF_CX + 128 * t + wi - 128; }
    if (vn < 14336) return OFF_GA + vn - 12288;
    return OFF_GB + vn - 14336;
}
struct CT { const float* src; bf16_t* dst; int ld, K, k0; float scale; int skip; };
DI int pcol0(int g4) { return 128 * (g4 & 1) + 32 * (g4 >> 1); }
constexpr int DT_D0 = 0, DT_D1 = DT_D0 + 1536, DT_D1B = DT_D1 + 2816, DT_D2 = DT_D1B + 1408, DT_D2B = DT_D2 + 4096, DT_D2C = DT_D2B + 16, DT_D3 = DT_D2C + 1536, DT_D3B = DT_D3 + 8 * 2816, DT_END = DT_D3B + 8 * 1408;
DI CT conv_sq(const Params& p, unsigned char* ws, int l, int u) {
    const int kt = u & 15, g = (u >> 4) & 31, which = u >> 9;
    const float* src = (which == 0 ? p.w_proj_a : which == 1 ? p.w_proj_b : p.w_out) + (size_t)l * D * D + (g >> 2) * 256 + pcol0(g & 3);
    bf16_t* dst = (bf16_t*)(ws + (which == 0 ? WS_WA : which == 1 ? WS_WB : WS_WO)) + ((size_t)l * D + g * 64) * D;
    return CT{src, dst, D, D, kt * 128, 1.f, 32};
}
DI CT conv_up(const Params& p, unsigned char* ws, int e, int u) {
    const int kt = u & 15, g = u >> 4, t = (g * 64) >> 8, wi = (g * 64) & 255;
    const float* w1 = e == 8 ? p.ffn_w1 : p.moe_w1 + (size_t)e * D * DFF; const float* w3 = e == 8 ? p.ffn_w3 : p.moe_w3 + (size_t)e * D * DFF;
    const float* src = wi < 128 ? w1 + 128 * t + wi : w3 + 128 * t + wi - 128;
    bf16_t* dst = (e == 8 ? (bf16_t*)(ws + WS_F1) : (bf16_t*)(ws + WS_M1) + (size_t)e * 11264 * D) + (size_t)g * 64 * D;
    return CT{src, dst, DFF, D, kt * 128, 1.f, 0};
}
DI CT conv_down(const Params& p, unsigned char* ws, int e, int u) {
    const int kt = u % 44, g = u / 44;
    const float* src = (e == 8 ? p.ffn_w2 : p.moe_w2 + (size_t)e * DFF * D) + (g >> 2) * 256 + pcol0(g & 3);
    bf16_t* dst = (e == 8 ? (bf16_t*)(ws + WS_F2) : (bf16_t*)(ws + WS_M2) + (size_t)e * D * DFF) + (size_t)g * 64 * DFF;
    return CT{src, dst, D, DFF, kt * 128, 1.f, 32};
}
DI CT conv_win(const Params& p, unsigned char* ws, int l, int u) {
    const int kt = u & 15, g = u >> 4, T = g >> 2; const bool plain = T < 32 || T >= 48;
    return CT{p.w_in + (size_t)l * D * NIN + (plain ? win_src_col(T * 256) + pcol0(g & 3) : win_src_col(g * 64)), (bf16_t*)(ws + WS_WIN) + ((size_t)l * 16384 + g * 64) * D, NIN, D, kt * 128, g < 16 ? 0.0625f : 1.f, plain ? 32 : 0};
}
DI CT conv_wg(const Params& p, unsigned char* ws, int l, int u) { return CT{p.w_in + (size_t)l * D * NIN + OFF_AF, (bf16_t*)(ws + WS_WG) + (size_t)l * 64 * D, NIN, D, (u & 15) * 128, 1.f, 0}; }
DI CT conv_deferred(const Params& p, unsigned char* ws, int i) {
    if (i < DT_D1) return conv_sq(p, ws, 0, i - DT_D0);
    if (i < DT_D1B) return conv_up(p, ws, 8, i - DT_D1);
    if (i < DT_D2) return conv_down(p, ws, 8, i - DT_D1B);
    if (i < DT_D2B) return conv_win(p, ws, 1, i - DT_D2);
    if (i < DT_D2C) return conv_wg(p, ws, 1, i - DT_D2B);
    if (i < DT_D3) return conv_sq(p, ws, 1, i - DT_D2C);
    if (i < DT_D3B) { const int u = i - DT_D3; return conv_up(p, ws, u / 2816, u % 2816); }
    const int u = i - DT_D3B; return conv_down(p, ws, u / 1408, u % 1408);
}
struct CReg { float4 v[4]; };
DI void conv_load(const CT& c, CReg& r) { const int tid = threadIdx.x;
#pragma unroll
    for (int ps = 0; ps < 4; ++ps) { const f32x4 t = __builtin_nontemporal_load((const f32x4*)(c.src + (size_t)(c.k0 + ps * 32 + (tid >> 4)) * c.ld + (tid & 15) * 4 + ((tid >> 3) & 1) * c.skip)); r.v[ps] = make_float4(t[0], t[1], t[2], t[3]); } }
DI void conv_to_lds(const CReg& r, float* tile) { const int tid = threadIdx.x;
#pragma unroll
    for (int ps = 0; ps < 4; ++ps) { float* t = tile + (ps * 32 + (tid >> 4)) * 65 + (tid & 15) * 4; t[0] = r.v[ps].x; t[1] = r.v[ps].y; t[2] = r.v[ps].z; t[3] = r.v[ps].w; } }
DI void conv_out(const CT& c, const float* tile) { const int tid = threadIdx.x;
#pragma unroll
    for (int ps = 0; ps < 2; ++ps) { const int n = ps * 32 + (tid >> 4), kc = (tid & 15) * 8; const float* t = tile + kc * 65 + n; const float sc = c.scale;
        u32x4 o; o.x = pg8::cvt_pk_bf16(t[0] * sc, t[65] * sc); o.y = pg8::cvt_pk_bf16(t[130] * sc, t[195] * sc); o.z = pg8::cvt_pk_bf16(t[260] * sc, t[325] * sc); o.w = pg8::cvt_pk_bf16(t[390] * sc, t[455] * sc);
        __builtin_nontemporal_store(o, (u32x4*)(c.dst + (size_t)n * c.K + c.k0 + kc)); } }
template <class F> DI void conv_stream(F desc, int begin, int end, int rank, int nshare, unsigned char* ldsb) {
    float* t0 = (float*)ldsb; float* t1 = t0 + 128 * 65;
    const int first = begin + rank; if (first >= end) return;
    const int n = (end - first + nshare - 1) / nshare;
    auto idx = [&](int j) { return first + (j < n ? j : n - 1) * nshare; };
#ifndef CONVREP
#define CONVREP 1
#endif
    for (int crep = 0; crep < CONVREP; ++crep) {
    CReg ra, rb; CT ca = desc(idx(0)), cb = desc(idx(1)); conv_load(ca, ra); conv_load(cb, rb);
    __syncthreads();
#pragma unroll 1
    for (int j = 0; j < n; j += 2) {
        conv_to_lds(ra, t0); const CT oa = ca; ca = desc(idx(j + 2)); conv_load(ca, ra);
        __syncthreads();
        conv_out(oa, t0);
        conv_to_lds(rb, t1); const CT ob = cb; cb = desc(idx(j + 3)); conv_load(cb, rb);
        __syncthreads();
        if (j + 1 < n) conv_out(ob, t1);
    }
    __syncthreads();
    }
}
DI void ph_convert(const Params& p, unsigned char* ws, int bid, int nblk, unsigned char* ldsb) {
    conv_stream([&](int i) { return i < 4096 ? conv_win(p, ws, 0, i) : conv_wg(p, ws, 0, i - 4096); }, 0, 4096 + 16, bid, nblk, ldsb);
}
#ifndef SLOT_T58
#define SLOT_T58 24
#endif
#ifndef SLOT_G2
#define SLOT_G2 88
#endif
#ifndef SLOT_G1
#define SLOT_G1 7
#endif
constexpr int NSLOT = 10;
constexpr int SLOT_N[NSLOT] = {192 * SLOT_G1, 128 * SLOT_G2, 224 * SLOT_T58, 224 * SLOT_T58, 128 * (SLOT_T58 * 14 / 58), 208 * SLOT_T58, 128 * (SLOT_T58 * 33 / 58), 192 * SLOT_T58, 192 * SLOT_G1, 128 * SLOT_G2};
constexpr int slot_begin(int s) { int b = 0; for (int i = 0; i < s; ++i) b += SLOT_N[i]; return b < DT_END ? b : DT_END; }
static_assert(slot_begin(2) >= DT_D1, "w_proj_a/b, w_out of layer 0 must be converted before proj-a L0");
static_assert(slot_begin(5) >= DT_D2, "the dense FFN weights must be converted before FFN-up L0");
static_assert(slot_begin(7) >= DT_D3, "layer-1 in-projection / projection weights must be converted before in-proj L1");
DI void conv_slot(const Params& p, int s_begin, int s_end, int total, int bid, int nblk, unsigned char* ldsb) {
    if (!(FAST & FB_CONV) || s_begin >= s_end) return;
    const int rem = total % nblk;
    int rank, nshare; if (rem == 0) { rank = bid; nshare = nblk; } else { if (bid < rem) return; rank = bid - rem; nshare = nblk - rem; }
    conv_stream([&](int i) { return conv_deferred(p, p.ws, i); }, s_begin, s_end, rank, nshare, ldsb);
}
DI void conv_slot_direct(const Params& p, int s_begin, int s_end, int rank, int nshare, unsigned char* ldsb) {
    if (!(FAST & FB_CONV) || s_begin >= s_end || nshare <= 0) return;
    conv_stream([&](int i) { return conv_deferred(p, p.ws, i); }, s_begin, s_end, rank, nshare, ldsb);
}
#define CONV_SLOT(s, total) conv_slot(p, slot_begin(s), slot_begin((s) + 1), (total), bid, nblk, lds)

template <int L> DI void ph_gate_fast(const Ws& w, int bid, int nblk) {
    const int lane = threadIdx.x & 63, wave = threadIdx.x >> 6, fr = lane & 15, fq = lane >> 4;
    const bf16_t* wg = (const bf16_t*)(w.b + WS_WG) + (size_t)L * 64 * D;
    for (int t = wave * nblk + bid; t < MT / 16; t += 8 * nblk) {
        f32x4 a0 = {0.f, 0.f, 0.f, 0.f}, a1 = {0.f, 0.f, 0.f, 0.f};
        const bf16_t* ap = w.h_() + (size_t)(t * 16 + fr) * D + fq * 8; const bf16_t* bp0 = wg + (size_t)fr * D + fq * 8; const bf16_t* bp1 = bp0 + 16 * D;
#pragma unroll 8
        for (int k0 = 0; k0 < D; k0 += 32) { const pg8::bf16x8 a = *(const pg8::bf16x8*)(ap + k0), b0 = *(const pg8::bf16x8*)(bp0 + k0), b1 = *(const pg8::bf16x8*)(bp1 + k0);
            a0 = __builtin_amdgcn_mfma_f32_16x16x32_bf16(a, b0, a0, 0, 0, 0); a1 = __builtin_amdgcn_mfma_f32_16x16x32_bf16(a, b1, a1, 0, 0, 0); }
#pragma unroll
        for (int j = 0; j < 4; ++j) { float* o = w.pg_() + (size_t)(t * 16 + 4 * fq + j) * 32; o[fr] = a0[j]; o[16 + fr] = a1[j]; }
    }
}

#define GLDS(lds) ((LAS unsigned char*)(lds))
template <int L> DI void ph_inproj_fast(const Params& p, const Ws& w, int bid, int nblk, unsigned char* lds) {
    Gemm g{w.h_(), (const bf16_t*)(w.b + WS_WIN) + (size_t)L * 16384 * D, MT, 16384, D};
    RectOrder S; if (L == 0) S.init2(MT, 16384, nblk, bid, 0, 0); else S.init2(ML, 16384, nblk, bid, MC / 256, 16);
    EpiInproj E{w.P_()};
    pg8::gemm_phase<EpiInproj, RectOrder, true, true>(GLDS(lds), g, S, E);
    ph_gate_fast<L>(w, bid, nblk);
    if (L == 1) CONV_SLOT(7, 2048 + 64);
}
template <int L> DI void ph_pa_fast(const Params& p, const Ws& w, int bid, int nblk, unsigned char* lds) {
    constexpr int MR = L == 0 ? MT : ML;
    Gemm g{w.ya_(), (const bf16_t*)(w.b + WS_WA) + (size_t)L * D * D, MR, D, D}; pg8::StaticOrder S; S.init(MR, D, nblk, bid);
    EpiGateA E{w.ma_(), w.P_(), PGA};
    pg8::gemm_phase<EpiGateA, pg8::StaticOrder, true, true>(GLDS(lds), g, S, E);
    if (L == 0) CONV_SLOT(2, 288);
}
template <int L> DI void ph_pb_fast(const Params& p, const Ws& w, int bid, int nblk, unsigned char* lds) {
    constexpr int MR = L == 0 ? MT : ML;
    Gemm g{w.obr_(), (const bf16_t*)(w.b + WS_WB) + (size_t)L * D * D, MR, D, D}; pg8::StaticOrder S; S.init(MR, D, nblk, bid);
    EpiGateB E{w.mrg_(), w.ma_(), w.P_(), PGB};
    pg8::gemm_phase<EpiGateB, pg8::StaticOrder, true, true>(GLDS(lds), g, S, E);
    if (L == 0) CONV_SLOT(3, 288);
}
template <int L> DI void ph_wo_fast(const Params& p, const Ws& w, int bid, int nblk, unsigned char* lds) {
    Gemm g{w.mrg_(), (const bf16_t*)(w.b + WS_WO) + (size_t)L * D * D, L == 0 ? MT : ML, D, D};
    SplitOrder S; S.init2(ML, D, nblk, bid, L == 0 ? MC / 256 : 0, D);
    EpiF32 E{w.mm_(), (float*)(w.b + WS_MMP), ML, MC};
    pg8::gemm_phase<EpiF32, SplitOrder, true, true>(GLDS(lds), g, S, E);
    if (L == 0) CONV_SLOT(4, 256 + 128);
}
DI const LAS unsigned char* moe_panel_table(const Ws& w, unsigned char* lds, int& npanels) {
    int off[9]; moe_offsets(w, off); npanels = off[8] >> 8;
    LAS unsigned char* pe = (LAS unsigned char*)(lds + 131072 + 1024);
    __syncthreads();
    if (threadIdx.x < 80) { const int m0 = (int)threadIdx.x * 256; pe[threadIdx.x] = (unsigned char)expert_of_row(off, m0); }
    __syncthreads();
    return pe;
}
template <int L> DI void ph_f1_fast(const Params& p, const Ws& w, int bid, int nblk, unsigned char* lds) {
    if (L == 0) {
        Gemm g{w.h_(), (const bf16_t*)(w.b + WS_F1), MT, 11264, D}; pg8::StaticOrder S; S.init(MT, 11264, nblk, bid);
        EpiSwiglu E{w.gg_()};
        pg8::gemm_phase<EpiSwiglu, pg8::StaticOrder, true, true>(GLDS(lds), g, S, E);
        CONV_SLOT(5, 36 * 44);
    } else {
        int np; const LAS unsigned char* pe = moe_panel_table(w, lds, np);
        Gemm g{w.hs_(), (const bf16_t*)(w.b + WS_M1), np * 256, 11264, D}; MoeOrder S; S.init(np * 256, 11264, nblk, bid); S.pe = pe;
        EpiSwiglu E{w.gg_()};
        pg8::gemm_phase<EpiSwiglu, MoeOrder, true, true>(GLDS(lds), g, S, E);
    }
}
template <int L> DI void ph_f2_fast(const Params& p, const Ws& w, int bid, int nblk, unsigned char* lds) {
    if (L == 0) {
        Gemm g{w.gg_(), (const bf16_t*)(w.b + WS_F2), MT, D, DFF}; SplitOrder S; S.init2(ML, D, nblk, bid, MC / 256, DFF);
        EpiF32 E{w.mm_(), (float*)(w.b + WS_MMP), ML, MC};
        pg8::gemm_phase<EpiF32, SplitOrder, true, true>(GLDS(lds), g, S, E);
        CONV_SLOT(6, 256 + 128);
    } else {
        int np; const LAS unsigned char* pe = moe_panel_table(w, lds, np);
        Gemm g{w.gg_(), (const bf16_t*)(w.b + WS_M2), np * 256, D, DFF}; MoeOrderT<true> S; S.init2(64 * 256, D, nblk, bid, np - 64, DFF); S.pe = pe;
        EpiF32 E{w.ys_(), (float*)(w.b + WS_YSP), 64 * 256, 2048};
        pg8::gemm_phase<EpiF32, MoeOrderT<true>, true, true>(GLDS(lds), g, S, E);
    }
}

typedef pg8::bf16x8 bf16x8;
typedef short s16x4 __attribute__((ext_vector_type(4)));
DI bf16x8 ldg8(const bf16_t* p) { return *(const bf16x8*)p; }
DI bf16x8 lds8(const LAS unsigned char* p) { return *(const LAS bf16x8*)p; }
#define MFMA16(a, b, c) __builtin_amdgcn_mfma_f32_16x16x32_bf16((a), (b), (c), 0, 0, 0)
DI bf16x8 lds_tr8(const LAS unsigned char* img, int pitch, int lane) {
#if defined(__HIP_DEVICE_COMPILE__)
    const int g = lane >> 4, q = (lane & 15) >> 2, pp = lane & 3;
    const LAS unsigned char* a = img + (8 * g + q) * pitch + 8 * pp;
    const s16x4 lo = __builtin_amdgcn_ds_read_tr16_b64_v4i16((LAS s16x4*)a), hi = __builtin_amdgcn_ds_read_tr16_b64_v4i16((LAS s16x4*)(a + 4 * pitch));
    return __builtin_shufflevector(lo, hi, 0, 1, 2, 3, 4, 5, 6, 7);
#else
    return bf16x8{};
#endif
}
DI u32x4 lds_ld16(const LAS unsigned char* p) {
#if defined(__HIP_DEVICE_COMPILE__)
    return *(const LAS u32x4*)p;
#else
    return u32x4{};
#endif
}
DI void lds_st16(LAS unsigned char* p, u32x4 v) {
#if defined(__HIP_DEVICE_COMPILE__)
    *(LAS u32x4*)p = v;
#endif
}
DI void lds_st8(LAS unsigned char* p, u32x2 v) {
#if defined(__HIP_DEVICE_COMPILE__)
    *(LAS u32x2*)p = v;
#endif
}

DI float lsig2(float x) { const float y = x * 1.44269504f; return (fminf(y, 0.f) - __builtin_amdgcn_logf(1.f + __builtin_amdgcn_exp2f(-fabsf(y)))) * 0.0625f; }
template <int L> DI void ph_g1_fast(const Params& p, const Ws& w, int bid, int nblk, unsigned char* ldsb) {
    constexpr int RS = 544, QT_OFF = 0, KT_OFF = 2 * 64 * RS, A_OFF = 4 * 64 * RS, ARS = 144, VRS = 144;
    LAS unsigned char* lds = (LAS unsigned char*)ldsb;
    float* pg_s = (float*)(ldsb + A_OFF);
    const int tid = threadIdx.x, d = tid >> 8, k = tid & 255, lane = tid & 63, wv = tid >> 6, fr = lane & 15, fq = lane >> 4;
    for (int u = bid; u < NCH * NH; u += nblk) {
        const int cg = u >> 2, h = u & 3, r0 = cg * 64;
        __syncthreads();
        for (int i = tid; i < 64 * 32; i += 512) pg_s[i] = w.pg_()[(size_t)r0 * 32 + i];
        const int kw = (wv & 3) * 64;
        const float* w2 = (d == 0 ? p.gate_w2_f : p.gate_w2_b) + (size_t)L * 16 * 1024 + h * 256 + kw;
        const float* bv = (d == 0 ? p.gate_b_f : p.gate_b_b) + L * 1024 + h * 256 + kw;
        s16x4 bw[4]; float bias4[4];
#pragma unroll
        for (int kb = 0; kb < 4; ++kb) { const float* c0 = w2 + (4 * fq) * 1024 + 16 * kb + fr;
            const unsigned lo = pg8::cvt_pk_bf16(c0[0], c0[1024]), hi = pg8::cvt_pk_bf16(c0[2048], c0[3072]);
            bw[kb] = __builtin_bit_cast(s16x4, (u32x2){lo, hi}); bias4[kb] = bv[16 * kb + fr]; }
        __syncthreads();
        float totk[4] = {0.f, 0.f, 0.f, 0.f};
#pragma unroll
        for (int m = 0; m < 4; ++m) {
            const f32x4 pa = *(const LAS f32x4*)(lds + A_OFF + ((16 * m + fr) * 32 + 16 * d + 4 * fq) * 4);
            const s16x4 af = __builtin_bit_cast(s16x4, (u32x2){pg8::cvt_pk_bf16(pa[0], pa[1]), pg8::cvt_pk_bf16(pa[2], pa[3])});
#pragma unroll
            for (int kb = 0; kb < 4; ++kb) {
                const f32x4 x = __builtin_amdgcn_mfma_f32_16x16x16bf16_1k(af, bw[kb], (f32x4){bias4[kb], bias4[kb], bias4[kb], bias4[kb]}, 0, 0, 0);
                const int l = 16 * kb + fr, la_o = (l < 32 ? QT_OFF : KT_OFF) + d * 64 * RS + 128 * (wv & 3) + 4 * (l & 31);
#pragma unroll
                for (int i = 0; i < 4; ++i) { const float la = lsig2(x[i]); totk[kb] += la; *(LAS float*)(lds + la_o + (16 * m + 4 * fq + i) * RS) = la; }
            }
        }
#pragma unroll
        for (int kb = 0; kb < 4; ++kb) { totk[kb] += __shfl_xor(totk[kb], 16); totk[kb] += __shfl_xor(totk[kb], 32); }
        const float tot = fq == 0 ? totk[0] : fq == 1 ? totk[1] : fq == 2 ? totk[2] : totk[3];
        const int la_off = ((k & 63) < 32 ? QT_OFF : KT_OFF) + d * 64 * RS + 128 * ((k >> 6) & 3) + 4 * (k & 31);
        float cum = 0.f;
        const bf16_t* qbase = w.P_() + (size_t)r0 * LDP + PQ + h * 256 + k; const bf16_t* kbase = w.P_() + (size_t)r0 * LDP + PK + h * 256 + k;
        auto load_blk = [&](int c, bf16_t (&qv_)[8], bf16_t (&kv_)[8]) {
#pragma unroll
            for (int i = 0; i < 8; ++i) { const int t = d ? 63 - (c * 8 + i) : c * 8 + i; qv_[i] = qbase[(size_t)t * LDP]; kv_[i] = kbase[(size_t)t * LDP]; } };
        auto do_blk = [&](int c, const bf16_t (&qv_)[8], const bf16_t (&kv_)[8]) {
            bf16_t kev[8];
#pragma unroll
            for (int i = 0; i < 8; ++i) {
                const int t = d ? 63 - (c * 8 + i) : c * 8 + i;
                cum += *(const LAS float*)(lds + la_off + t * RS);
                const float q = bf2f(qv_[i]), kk = bf2f(kv_[i]);
                const unsigned qk = pg8::cvt_pk_bf16(q * __builtin_amdgcn_exp2f(cum), kk * __builtin_amdgcn_exp2f(-cum));
                const bf16_t qtv = (bf16_t)(qk & 0xffffu), ktv = (bf16_t)(qk >> 16);
                kev[i] = (bf16_t)(pg8::cvt_pk_bf16(kk * __builtin_amdgcn_exp2f(tot - cum), 0.f) & 0xffffu);
                *(LAS bf16_t*)(lds + QT_OFF + (d * 64 + t) * RS + k * 2) = qtv; *(LAS bf16_t*)(lds + KT_OFF + (d * 64 + t) * RS + k * 2) = ktv;
                asm volatile("" ::: "memory");
            }
            const int t0 = d ? 56 - c * 8 : c * 8;
            uint4 o;
            o.x = d ? ((unsigned)kev[7] | ((unsigned)kev[6] << 16)) : ((unsigned)kev[0] | ((unsigned)kev[1] << 16));
            o.y = d ? ((unsigned)kev[5] | ((unsigned)kev[4] << 16)) : ((unsigned)kev[2] | ((unsigned)kev[3] << 16));
            o.z = d ? ((unsigned)kev[3] | ((unsigned)kev[2] << 16)) : ((unsigned)kev[4] | ((unsigned)kev[5] << 16));
            o.w = d ? ((unsigned)kev[1] | ((unsigned)kev[0] << 16)) : ((unsigned)kev[6] | ((unsigned)kev[7] << 16));
            *(uint4*)(w.ket_() + ((((size_t)d * NCH + cg) * 4 + h) * 256 + k) * 64 + t0) = o;
        };
        { bf16_t qA[8], kA[8], qB[8], kB[8];
          load_blk(0, qA, kA);
#pragma unroll 1
          for (int c = 0; c < 8; c += 2) { load_blk(c + 1, qB, kB); do_blk(c, qA, kA); load_blk(c + 2 < 8 ? c + 2 : 7, qA, kA); do_blk(c + 1, qB, kB); } }
        w.gd_()[((size_t)d * NCH + cg) * 1024 + h * 256 + k] = __builtin_amdgcn_exp2f(tot);
        __syncthreads();
#pragma unroll
        for (int i = 0; i < 8; ++i) { const int idx = tid + i * 512, row = idx >> 5, pc = idx & 31;
            *(u32x4*)(w.qt_() + ((size_t)(row >> 6) * MT + r0 + (row & 63)) * 1024 + h * 256 + pc * 8) = lds_ld16(lds + QT_OFF + row * RS + pc * 16); }
        if (L == 1 && cg >= 128) continue;
        { const int mi = wv & 3;
#pragma unroll
          for (int sb = 0; sb < 2; ++sb) { const int si = 2 * (wv >> 2) + sb;
              f32x4 af = {0.f, 0.f, 0.f, 0.f}, ab = {0.f, 0.f, 0.f, 0.f};
              if (si <= mi) {
#pragma unroll
                  for (int ks = 0; ks < 8; ++ks) af = MFMA16(lds8(lds + KT_OFF + (16 * si + fr) * RS + (32 * ks + 8 * fq) * 2), lds8(lds + QT_OFF + (16 * mi + fr) * RS + (32 * ks + 8 * fq) * 2), af); }
              if (si >= mi) {
#pragma unroll
                  for (int ks = 0; ks < 8; ++ks) ab = MFMA16(lds8(lds + KT_OFF + (64 + 16 * si + fr) * RS + (32 * ks + 8 * fq) * 2), lds8(lds + QT_OFF + (64 + 16 * mi + fr) * RS + (32 * ks + 8 * fq) * 2), ab); }
              float v[4];
#pragma unroll
              for (int r = 0; r < 4; ++r) { const int sl = 16 * si + 4 * fq + r, tl = 16 * mi + fr; v[r] = (sl <= tl ? af[r] : 0.f) + (sl >= tl ? ab[r] : 0.f); }
              asm volatile("s_nop 0" ::: "memory");
              u32x2 pk; pk.x = pg8::cvt_pk_bf16(v[0], v[1]); pk.y = pg8::cvt_pk_bf16(v[2], v[3]);
              lds_st8(lds + A_OFF + (16 * mi + fr) * ARS + (16 * si + 4 * fq) * 2, pk); } }
        __syncthreads();
        constexpr int VP = 1056;
#pragma unroll
        for (int i = 0; i < 8; ++i) { const int idx = tid + i * 512, sr = idx >> 6, pc = idx & 63;
            lds_st16(lds + sr * VP + pc * 16, *(const u32x4*)(w.P_() + (size_t)(r0 + sr) * LDP + PV + h * 512 + pc * 8)); }
        __syncthreads();
        { f32x4 acc[4][4];
#pragma unroll
          for (int nb = 0; nb < 4; ++nb)
#pragma unroll
              for (int mb = 0; mb < 4; ++mb) acc[nb][mb] = (f32x4){0.f, 0.f, 0.f, 0.f};
#pragma unroll
          for (int ks = 0; ks < 2; ++ks) { bf16x8 af[4], vf[4];
#pragma unroll
              for (int mb = 0; mb < 4; ++mb) af[mb] = lds8(lds + A_OFF + (16 * mb + fr) * ARS + (32 * ks + 8 * fq) * 2);
#pragma unroll
              for (int nb = 0; nb < 4; ++nb) vf[nb] = lds_tr8(lds + (32 * ks) * VP + (64 * wv + 16 * nb) * 2, VP, lane);
#pragma unroll
              for (int nb = 0; nb < 4; ++nb)
#pragma unroll
                  for (int mb = 0; mb < 4; ++mb) acc[nb][mb] = MFMA16(vf[nb], af[mb], acc[nb][mb]); }
#pragma unroll
          for (int nb = 0; nb < 4; ++nb)
#pragma unroll
              for (int mb = 0; mb < 4; ++mb) { u32x2 pk; pk.x = pg8::cvt_pk_bf16(acc[nb][mb][0], acc[nb][mb][1]); pk.y = pg8::cvt_pk_bf16(acc[nb][mb][2], acc[nb][mb][3]);
                  *(u32x2*)(w.oi_() + (size_t)(r0 + 16 * mb + fr) * D + h * 512 + 64 * wv + 16 * nb + 4 * fq) = pk; } }
    }
    { unsigned char* lds = ldsb; CONV_SLOT(L == 0 ? 0 : 8, NCH * NH); }
}

DI int st_addr(int n, int kbyte) { return n * 528 + kbyte; }
template <int L> DI void ph_g2_fast(const Params& p, const Ws& w, int bid, int nblk, unsigned char* ldsb) {
    constexpr int VRS = 288, VTB = 64 * VRS, V_OFF = 128 * 528, G_OFF = V_OFF + 2 * VTB;
    LAS unsigned char* lds = (LAS unsigned char*)ldsb;
    const int tid = threadIdx.x, lane = tid & 63, wv = tid >> 6, fr = lane & 15, fq = lane >> 4, mq = wv & 3, nh = wv >> 2;
    const int ng2 = nblk >= 256 ? 128 : nblk;
    if (bid >= ng2) { conv_slot_direct(p, slot_begin(L == 0 ? 1 : 9), slot_begin(L == 0 ? 2 : 10), bid - ng2, nblk - ng2, ldsb); return; }
    for (int u = bid; u < 128; u += ng2) {
        const int xcd = u & 7, idx = u >> 3, chain = xcd * 4 + (idx >> 2), j = idx & 3, d = chain & 1, h = (chain >> 1) & 3, b = chain >> 3;
        auto chunk_of = [&](int step) { return step < 4 ? 128 + b * 4 + (d ? 3 - step : step) : b * 32 + (d ? 31 - (step - 4) : (step - 4)); };
        auto vsrc = [&](int step) { return (const u32x4*)(w.P_() + (size_t)(chunk_of(step) * 64 + (tid >> 3)) * LDP + PV + h * 512 + j * 128 + (tid & 7) * 16); };
        auto vpark = [&](int stage, const u32x4 a0, const u32x4 a1) { LAS unsigned char* q = lds + V_OFF + stage * VTB + (tid >> 3) * VRS + (tid & 7) * 32; lds_st16(q, a0); lds_st16(q + 16, a1); };
        auto gsrc = [&](int step) { return (const u32x4*)(w.gd_() + ((size_t)d * NCH + chunk_of(step)) * 1024 + h * 256 + (tid & 63) * 4); };
        auto gpark = [&](int stage, const u32x4 g4) { if (tid < 64) lds_st16(lds + G_OFF + stage * 1024 + tid * 16, g4); };
        __syncthreads();
        for (int i = tid; i < 128 * 528 / 16; i += 512) lds_st16(lds + i * 16, (u32x4){0u, 0u, 0u, 0u});
        { const u32x4* s0 = vsrc(0); vpark(0, s0[0], s0[1]); gpark(0, *gsrc(0)); }
        __syncthreads();
        f32x4 S[2][8];
#pragma unroll
        for (int kb = 0; kb < 2; ++kb)
#pragma unroll
            for (int nb = 0; nb < 8; ++nb) S[kb][nb] = (f32x4){0.f, 0.f, 0.f, 0.f};
        bf16x8 ke[2][2], qa[8];
        auto load_upd = [&](int step, bf16x8 (&ke_)[2][2]) {
            const int cg = chunk_of(step);
            const bf16_t* kep = w.ket_() + ((((size_t)d * NCH + cg) * 4 + h) * 256 + 32 * wv) * 64;
#pragma unroll
            for (int kb = 0; kb < 2; ++kb)
#pragma unroll
                for (int s2 = 0; s2 < 2; ++s2) ke_[kb][s2] = ldg8(kep + (16 * kb + fr) * 64 + 32 * s2 + 8 * fq);
        };
        auto load_q = [&](int step) {
            const bf16_t* qtp = w.qt_() + ((size_t)d * MT + chunk_of(step) * 64 + 16 * mq + fr) * 1024 + h * 256;
#pragma unroll
            for (int s8 = 0; s8 < 8; ++s8) qa[s8] = ldg8(qtp + 32 * s8 + 8 * fq);
        };
        auto compute_step = [&](int step, const bf16x8 (&ke_)[2][2], const u32x4 vn0, const u32x4 vn1, const u32x4 gn) {
            const int cg = chunk_of(step), cur = step & 1;
            f32x4 gv_[2];
#pragma unroll
            for (int kb = 0; kb < 2; ++kb) gv_[kb] = *(const LAS f32x4*)(lds + G_OFF + cur * 1024 + (32 * wv + 16 * kb + 4 * fq) * 4);
#pragma unroll
            for (int kb = 0; kb < 2; ++kb)
#pragma unroll
                for (int nb = 0; nb < 8; ++nb) S[kb][nb] = S[kb][nb] * gv_[kb];
#pragma unroll
            for (int s2 = 0; s2 < 2; ++s2)
#pragma unroll
                for (int nb = 0; nb < 8; ++nb) { const bf16x8 vf = lds_tr8(lds + V_OFF + cur * VTB + (32 * s2) * VRS + (16 * nb) * 2, VRS, lane);
#pragma unroll
                    for (int kb = 0; kb < 2; ++kb) S[kb][nb] = MFMA16(ke_[kb][s2], vf, S[kb][nb]);
                    if (nb & 1) asm volatile("" ::: "memory"); }
            if (L == 0 || cg < 128)
#pragma unroll
            for (int hb = 0; hb < 2; ++hb) {
                f32x4 O[2] = {(f32x4){0.f, 0.f, 0.f, 0.f}, (f32x4){0.f, 0.f, 0.f, 0.f}};
#pragma unroll
                for (int s8 = 0; s8 < 8; ++s8)
#pragma unroll
                    for (int n2 = 0; n2 < 2; ++n2) O[n2] = MFMA16(lds8(lds + st_addr(64 * nh + 32 * hb + 16 * n2 + fr, (32 * s8 + 8 * fq) * 2)), qa[s8], O[n2]);
#pragma unroll
                for (int n2 = 0; n2 < 2; ++n2) { u32x2 pk; pk.x = pg8::cvt_pk_bf16(O[n2][0], O[n2][1]); pk.y = pg8::cvt_pk_bf16(O[n2][2], O[n2][3]);
                    *(u32x2*)(w.of_() + ((size_t)d * MT + cg * 64 + 16 * mq + fr) * D + h * 512 + j * 128 + 64 * nh + 32 * hb + 16 * n2 + 4 * fq) = pk; }
            }
            load_q(step + 1 < 36 ? step + 1 : 35);
            asm volatile("s_waitcnt lgkmcnt(0)" ::: "memory"); __builtin_amdgcn_s_barrier(); asm volatile("" ::: "memory");
#pragma unroll
            for (int kb = 0; kb < 2; ++kb)
#pragma unroll
                for (int nb = 0; nb < 8; ++nb) { u32x2 pk; pk.x = pg8::cvt_pk_bf16(S[kb][nb][0], S[kb][nb][1]); pk.y = pg8::cvt_pk_bf16(S[kb][nb][2], S[kb][nb][3]);
                    lds_st8(lds + st_addr(16 * nb + fr, (32 * wv + 16 * kb + 4 * fq) * 2), pk); }
            vpark(cur ^ 1, vn0, vn1); gpark(cur ^ 1, gn);
            asm volatile("s_waitcnt lgkmcnt(0)" ::: "memory"); __builtin_amdgcn_s_barrier(); asm volatile("" ::: "memory");
        };
        load_upd(0, ke); load_q(0);
#pragma unroll 1
        for (int step = 0; step < 36; step += 2) {
            bf16x8 keN[2][2];
            { const u32x4* sb = vsrc(step + 1); const u32x4 vb0 = sb[0], vb1 = sb[1], gb = *gsrc(step + 1);
              load_upd(step + 1, keN);
              compute_step(step, ke, vb0, vb1, gb); }
            { const int sn = step + 2 < 36 ? step + 2 : 35; const u32x4* sa = vsrc(sn); const u32x4 va0 = sa[0], va1 = sa[1], ga = *gsrc(sn);
              load_upd(sn, ke);
              compute_step(step + 1, keN, va0, va1, ga); }
        }
    }
}

constexpr int LDS_BYTES = 155648;
constexpr int PH_ADA = 0, PH_MODFIN = 1, PH_T1 = 2, PH_L0 = 3, NPL = 12, NPH = PH_L0 + 2 * NPL;
constexpr int L_INPROJ = 0, L_G1 = 1, L_G2 = 2, L_G3 = 3, L_PA = 4, L_PB = 5, L_WO = 6, L_T2 = 7, L_SCAT = 8, L_F1 = 9, L_F2 = 10, L_T3 = 11;

#ifndef PHSEL
#define PHSEL(k) true
#endif
#ifndef REPEAT
#define REPEAT 0
#endif
constexpr int RB_CONV = 1, RB_INPROJ = 2, RB_G1 = 4, RB_G2 = 8, RB_G3 = 16, RB_PAB = 32, RB_WO = 64, RB_F1 = 128, RB_F2 = 256, RB_ADA = 512, RB_T1 = 1024, RB_SCAT = 2048;
#define REP(bit) for (int rep_ = 0; rep_ < ((REPEAT & (bit)) ? 2 : 1); ++rep_)
#define REP2(bit, call) do { if (REPEAT & (bit)) { call; } call; } while (0)
template <int L> DI void layer_phases(const Params& p, const Ws& w, int bid, int nblk, unsigned char* lds, const XcdBarrier& bar) {
    const int lo = p.ph_lo, hi = p.ph_hi, base = PH_L0 + L * NPL;
#define IN(k) (PHSEL(base + (k)) && lo <= base + (k) && base + (k) < hi)
#define SEAM(k) do { if (lo <= base + (k) && base + (k) + 1 < hi) xcd_barrier(bar); } while (0)
    if (IN(L_INPROJ)) { if (FAST & FB_INPROJ) REP2(RB_INPROJ, ph_inproj_fast<L>(p, w, bid, nblk, lds)); else ph_inproj_naive<L>(p, w, bid, nblk, lds); }
    SEAM(L_INPROJ);
    if (IN(L_G1)) REP(RB_G1) { if (FAST & FB_G1) ph_g1_fast<L>(p, w, bid, nblk, lds); else ph_g1_naive<L>(p, w, bid, nblk, lds); }
    SEAM(L_G1);
    if (IN(L_G2)) REP(RB_G2) { if (FAST & FB_G2) ph_g2_fast<L>(p, w, bid, nblk, lds); else ph_g2_naive<L>(p, w, bid, nblk, lds); }
    if (IN(L_G2) && (!(FAST & FB_G2) || nblk < 256)) conv_slot_direct(p, slot_begin(L == 0 ? 1 : 9), slot_begin(L == 0 ? 2 : 10), bid, nblk, lds);
    SEAM(L_G2);
    if (IN(L_G3)) REP(RB_G3) ph_g3<L>(p, w, bid, nblk);
    SEAM(L_G3);
    if (IN(L_PA)) REP(RB_PAB) { if (FAST & FB_PA) ph_pa_fast<L>(p, w, bid, nblk, lds); else ph_pa_naive<L>(p, w, bid, nblk, lds); }
    if (!((FAST & FB_PA) && (FAST & FB_PB))) SEAM(L_PA);
    if (IN(L_PB)) REP(RB_PAB) { if (FAST & FB_PB) ph_pb_fast<L>(p, w, bid, nblk, lds); else ph_pb_naive<L>(p, w, bid, nblk, lds); }
    SEAM(L_PB);
    if (IN(L_WO)) REP(RB_WO) { if (FAST & FB_WO) ph_wo_fast<L>(p, w, bid, nblk, lds); else ph_wo_naive<L>(p, w, bid, nblk, lds); }
    SEAM(L_WO);
    if (IN(L_T2)) ph_t2<L>(p, w, bid, nblk, lds);
    SEAM(L_T2);
    if (L == 1) { if (IN(L_SCAT)) REP(RB_SCAT) { if (FAST & FB_CONV) conv_stream([&](int i) { return conv_deferred(p, p.ws, i); }, slot_begin(NSLOT), DT_END, bid, nblk, lds);
        ph_scatter(p, w, bid, nblk); } SEAM(L_SCAT); }
    if (IN(L_F1)) { if (FAST & FB_F1) REP2(RB_F1, ph_f1_fast<L>(p, w, bid, nblk, lds)); else ph_f1_naive<L>(p, w, bid, nblk, lds); }
    SEAM(L_F1);
    if (IN(L_F2)) { if (FAST & FB_F2) REP2(RB_F2, ph_f2_fast<L>(p, w, bid, nblk, lds)); else ph_f2_naive<L>(p, w, bid, nblk, lds); }
    SEAM(L_F2);
    if (IN(L_T3)) ph_t3<L>(p, w, bid, nblk);
    if (L == 0) SEAM(L_T3);
#undef SEAM
#undef IN
}

__global__ void __launch_bounds__(512, 2) k_fwd(Params p) {
    extern __shared__ __attribute__((aligned(16))) unsigned char lds[];
    const Ws w = make_ws(p.ws);
    const int bid = blockIdx.x, nblk = gridDim.x;
    volatile LAS unsigned* bst = (volatile LAS unsigned*)(lds + LDS_BYTES - 16);
    if (threadIdx.x == 0) { bst[0] = 0u; bst[1] = 0u; bst[2] = 0u; bst[3] = 0u; }
    __syncthreads();
    XcdBarrier bar; bar.bar = w.ctl_() + CW_BAR; bar.x = 0; bar.st = bst;
    if (p.ph_hi - p.ph_lo > 1) bar = xcd_barrier_post(w.ctl_() + CW_BAR, bst);
    const int lo = p.ph_lo, hi = p.ph_hi;
#define SEAM0(k) do { if (lo <= (k) && (k) + 1 < hi) xcd_barrier(bar); } while (0)
    if (PHSEL(PH_ADA) && lo <= PH_ADA && PH_ADA < hi) { REP(RB_ADA) ph_ada(p, w, bid, nblk, lds); if (FAST & FB_CONV) REP(RB_CONV) ph_convert(p, p.ws, bid, nblk, lds); }
    SEAM0(PH_ADA);
    if (PHSEL(PH_MODFIN) && lo <= PH_MODFIN && PH_MODFIN < hi) ph_modfin(p, w, bid, nblk);
    SEAM0(PH_MODFIN);
    if (PHSEL(PH_T1) && lo <= PH_T1 && PH_T1 < hi) REP(RB_T1) ph_t1(p, w, bid, nblk);
    SEAM0(PH_T1);
#undef SEAM0
    layer_phases<0>(p, w, bid, nblk, lds, bar);
    layer_phases<1>(p, w, bid, nblk, lds, bar);
}

extern "C" void kernel_launch(void* const* d_in, const int* in_sizes, int n_in, void* d_out, int out_size, void* d_ws, size_t ws_size, hipStream_t stream) {
    static int grid = 0;
    if (grid == 0) {
        if (n_in != 28 || ws_size < WS_END2) { fprintf(stderr, "kernel_launch: expected 28 inputs and >= %zu bytes of workspace; got %d, %zu\n", (size_t)WS_END2, n_in, ws_size); grid = -1; return; }
        int dev = 0, cus = 0;
        if (hipGetDevice(&dev) != hipSuccess || hipDeviceGetAttribute(&cus, hipDeviceAttributeMultiprocessorCount, dev) != hipSuccess) { grid = -1; return; }
        if (hipFuncSetAttribute((const void*)k_fwd, hipFuncAttributeMaxDynamicSharedMemorySize, LDS_BYTES) != hipSuccess) { fprintf(stderr, "kernel_launch: hipFuncSetAttribute failed\n"); grid = -1; return; }
        grid = cus > 0 ? cus : 256;
    }
    if (grid < 0) return;
    (void)hipMemsetAsync((char*)d_ws + WS_CTL, 0, CTL_BYTES, stream);
    Params p{};
    const float** pp = (const float**)&p;
    for (int i = 0; i < 28; ++i) pp[i] = (const float*)d_in[i];
    p.out = (float*)d_out; p.ws = (unsigned char*)d_ws;
#ifndef MK_PER_PHASE
    p.ph_lo = 0; p.ph_hi = NPH;
    hipLaunchKernelGGL(k_fwd, dim3(grid), dim3(512), LDS_BYTES, stream, p);
#else
    for (int ph = 0; ph < NPH; ++ph) {
        if (ph == PH_L0 + L_SCAT) continue;
        p.ph_lo = ph; p.ph_hi = ph + 1;
        hipLaunchKernelGGL(k_fwd, dim3(grid), dim3(512), LDS_BYTES, stream, p);
    }
#endif
}
```
